# Optimizing an MI355X kernel written in HIP

```python
import math
import jax, jax.numpy as jnp
from jax import lax
import numpy as np

D_MODEL = 2048
BATCH = 1
SEQ = 16384
DEPTH = 1

S5_WIDTH = D_MODEL // 4
S5_GROUP = 16
S5_GROUPS = S5_WIDTH // S5_GROUP
S5_STATE = 64
LRU_WIDTH = 3 * D_MODEL // 4
LRU_HEADS = 12
LRU_HEAD_DIM = LRU_WIDTH // LRU_HEADS
CONV_WIDTH = 4
LRU_C = 8.0
IN_COLS = S5_WIDTH + 2 * LRU_WIDTH + 2 * D_MODEL
MOE_GROUPS = 4
EXPERTS_PER_GROUP = 8
N_EXPERTS = MOE_GROUPS * EXPERTS_PER_GROUP
TOP_K = 2
EXPERT_FF = D_MODEL // 8
NORM_EPS = 1e-6

kernel_name = 'hybrid_s5_rglru_hmoe_block'


def rms_norm(x, w):
    x32 = x.astype(jnp.float32)
    y = x32 * lax.rsqrt(jnp.mean(x32 * x32, axis=-1, keepdims=True) + NORM_EPS)
    return (y * w.astype(jnp.float32)).astype(x.dtype)


def _linear_combine(left, right):
    a_l, b_l = left
    a_r, b_r = right
    return a_r * a_l, a_r * b_l + b_r


def s5_branch(u, lam_re, lam_im, log_step, b_re, b_im, c_re, c_im, d_skip, w_glu, b_glu):
    bsz, seqlen, _ = u.shape
    f32 = jnp.float32
    u32 = u.astype(f32).reshape(bsz, seqlen, S5_GROUPS, S5_GROUP)
    lam = lax.complex(lam_re.astype(f32), lam_im.astype(f32))
    step = jnp.exp(log_step.astype(f32))[:, None]
    lam_bar = jnp.exp(lam * step)
    b_c = lax.complex(b_re.astype(f32), b_im.astype(f32))
    b_bar = ((lam_bar - 1.0) / lam)[..., None] * b_c
    bu = jnp.einsum('gpc,blgc->blgp', b_bar, u32.astype(jnp.complex64))
    a = jnp.broadcast_to(lam_bar, bu.shape)
    _, states = lax.associative_scan(_linear_combine, (a, bu), axis=1)
    c_c = lax.complex(c_re.astype(f32), c_im.astype(f32))
    y = jnp.real(jnp.einsum('gcp,blgp->blgc', c_c, states))
    y = y + d_skip.astype(f32).reshape(S5_GROUPS, S5_GROUP) * u32
    y = jax.nn.gelu(y.reshape(bsz, seqlen, S5_WIDTH))
    glu = jax.nn.sigmoid(y @ w_glu.astype(f32) + b_glu.astype(f32))
    return y * glu


def block_diag_linear(x, w, b):
    bsz, seqlen, _ = x.shape
    xh = x.reshape(bsz, seqlen, LRU_HEADS, LRU_HEAD_DIM)
    y = jnp.einsum('blhi,hij->blhj', xh, w.astype(x.dtype))
    return y.reshape(bsz, seqlen, LRU_WIDTH) + b.astype(x.dtype)


def rglru_branch(xb, yb, conv_w, conv_b, w_a, b_a, w_x, b_x, lam):
    f32 = jnp.float32
    seqlen = xb.shape[1]
    x32 = xb.astype(f32)
    xp = jnp.pad(x32, ((0, 0), (CONV_WIDTH - 1, 0), (0, 0)))
    xc = conv_b.astype(f32)
    for k in range(CONV_WIDTH):
        xc = xc + xp[:, k:k + seqlen] * conv_w[k].astype(f32)
    r = jax.nn.sigmoid(block_diag_linear(xc, w_a.astype(f32), b_a.astype(f32)))
    i = jax.nn.sigmoid(block_diag_linear(xc, w_x.astype(f32), b_x.astype(f32)))
    log_a = -LRU_C * r * jax.nn.softplus(-lam.astype(f32))
    a = jnp.exp(log_a)
    mult = jnp.sqrt(-jnp.expm1(2.0 * log_a))
    pos = jnp.arange(seqlen)[None, :, None]
    mult = jnp.where(pos == 0, 1.0, mult)
    _, h = lax.associative_scan(_linear_combine, (a, xc * i * mult), axis=1)
    return h * jax.nn.gelu(yb.astype(f32))


def mixer_sublayer(x, norm_w, w_in, b_gate, s5_lam_re, s5_lam_im, s5_log_step, s5_b_re, s5_b_im,
                   s5_c_re, s5_c_im, s5_d, s5_w_glu, s5_b_glu, lru_conv_w, lru_conv_b, lru_w_a,
                   lru_b_a, lru_w_x, lru_b_x, lru_lambda, w_proj_s5, w_proj_lru, w_out):
    h = rms_norm(x, norm_w)
    proj = h @ w_in
    o1 = S5_WIDTH
    o2 = o1 + LRU_WIDTH
    o3 = o2 + LRU_WIDTH
    u_s5 = proj[..., :o1]
    x_lru = proj[..., o1:o2]
    y_lru = proj[..., o2:o3]
    gates = jax.nn.sigmoid((proj[..., o3:] + b_gate).astype(jnp.float32))
    g_s5 = gates[..., :D_MODEL]
    g_lru = gates[..., D_MODEL:]
    out_s5 = s5_branch(u_s5, s5_lam_re, s5_lam_im, s5_log_step, s5_b_re, s5_b_im,
                       s5_c_re, s5_c_im, s5_d, s5_w_glu, s5_b_glu)
    out_lru = rglru_branch(x_lru, y_lru, lru_conv_w, lru_conv_b, lru_w_a, lru_b_a,
                           lru_w_x, lru_b_x, lru_lambda)
    br_s5 = out_s5.astype(x.dtype) @ w_proj_s5
    br_lru = out_lru.astype(x.dtype) @ w_proj_lru
    merged = (g_s5 * br_s5.astype(jnp.float32) + g_lru * br_lru.astype(jnp.float32)).astype(x.dtype)
    return x + merged @ w_out


def moe_sublayer(x, norm_w, w_rg, b_rg, w_re, b_re, w_e_gate, w_e_up, w_e_down):
    bsz, seqlen, d = x.shape
    f32 = jnp.float32
    ht = rms_norm(x, norm_w).reshape(bsz * seqlen, d)
    h32 = ht.astype(f32)
    g_prob = jax.nn.softmax(h32 @ w_rg.astype(f32) + b_rg.astype(f32), axis=-1)
    g_top, g_idx = lax.top_k(g_prob, 1)
    e_logits = (h32 @ w_re.astype(f32) + b_re.astype(f32)).reshape(-1, MOE_GROUPS, EXPERTS_PER_GROUP)
    e_sel = jnp.take_along_axis(e_logits, g_idx[:, :, None], axis=1)[:, 0]
    e_prob = jax.nn.softmax(e_sel, axis=-1)
    e_top, e_idx = lax.top_k(e_prob, TOP_K)
    e_top = e_top / jnp.sum(e_top, axis=-1, keepdims=True)
    weights = g_top * e_top
    expert_id = g_idx * EXPERTS_PER_GROUP + e_idx
    combine = jnp.sum(jax.nn.one_hot(expert_id, N_EXPERTS, dtype=f32) * weights[..., None], axis=1)
    gate = jnp.einsum('td,edf->tef', ht, w_e_gate)
    up = jnp.einsum('td,edf->tef', ht, w_e_up)
    act = jax.nn.silu(gate) * up * combine[:, :, None].astype(ht.dtype)
    out = jnp.einsum('tef,efd->td', act, w_e_down)
    return x + out.reshape(bsz, seqlen, d)


def setup_inputs(seed: int = 0) -> dict:
    key = jax.random.key(seed)
    ks = jax.random.split(key, 40)
    f32 = jnp.float32

    def nrm(k, shape, scale):
        return jax.random.normal(k, shape, f32) * scale

    G, P, GS = S5_GROUPS, S5_STATE, S5_GROUP
    x = nrm(ks[0], (BATCH, SEQ, D_MODEL), 1.0)
    norm_mix_w = 1.0 + nrm(ks[1], (DEPTH, D_MODEL), 0.02)
    w_in = nrm(ks[2], (DEPTH, D_MODEL, IN_COLS), D_MODEL ** -0.5)
    b_gate = nrm(ks[3], (DEPTH, 2 * D_MODEL), 0.02)
    s5_lam_re = -0.5 + nrm(ks[4], (DEPTH, G, P), 0.01)
    s5_lam_im = math.pi * jnp.arange(P, dtype=f32) + nrm(ks[5], (DEPTH, G, P), 0.01)
    s5_log_step = jax.random.uniform(ks[6], (DEPTH, G), f32, math.log(1e-3), math.log(1e-1))
    s5_b_re = nrm(ks[7], (DEPTH, G, P, GS), (2.0 * GS) ** -0.5)
    s5_b_im = nrm(ks[8], (DEPTH, G, P, GS), (2.0 * GS) ** -0.5)
    s5_c_re = nrm(ks[9], (DEPTH, G, GS, P), (2.0 * P) ** -0.5)
    s5_c_im = nrm(ks[10], (DEPTH, G, GS, P), (2.0 * P) ** -0.5)
    s5_d = nrm(ks[11], (DEPTH, S5_WIDTH), 1.0)
    s5_w_glu = nrm(ks[12], (DEPTH, S5_WIDTH, S5_WIDTH), S5_WIDTH ** -0.5)
    s5_b_glu = nrm(ks[13], (DEPTH, S5_WIDTH), 0.02)
    lru_conv_w = nrm(ks[14], (DEPTH, CONV_WIDTH, LRU_WIDTH), CONV_WIDTH ** -0.5)
    lru_conv_b = nrm(ks[15], (DEPTH, LRU_WIDTH), 0.02)
    lru_w_a = nrm(ks[16], (DEPTH, LRU_HEADS, LRU_HEAD_DIM, LRU_HEAD_DIM), LRU_HEAD_DIM ** -0.5)
    lru_b_a = nrm(ks[17], (DEPTH, LRU_WIDTH), 0.02)
    lru_w_x = nrm(ks[18], (DEPTH, LRU_HEADS, LRU_HEAD_DIM, LRU_HEAD_DIM), LRU_HEAD_DIM ** -0.5)
    lru_b_x = nrm(ks[19], (DEPTH, LRU_WIDTH), 0.02)
    a0 = jax.random.uniform(ks[20], (DEPTH, LRU_WIDTH), f32, 0.9, 0.999)
    s = a0 ** (1.0 / LRU_C)
    lru_lambda = jnp.log(s) - jnp.log1p(-s)
    w_proj_s5 = nrm(ks[21], (DEPTH, S5_WIDTH, D_MODEL), S5_WIDTH ** -0.5)
    w_proj_lru = nrm(ks[22], (DEPTH, LRU_WIDTH, D_MODEL), LRU_WIDTH ** -0.5)
    w_out = nrm(ks[23], (DEPTH, D_MODEL, D_MODEL), D_MODEL ** -0.5)
    norm_ffn_w = 1.0 + nrm(ks[24], (DEPTH, D_MODEL), 0.02)
    w_router_group = nrm(ks[25], (DEPTH, D_MODEL, MOE_GROUPS), D_MODEL ** -0.5)
    b_router_group = nrm(ks[26], (DEPTH, MOE_GROUPS), 0.01)
    w_router_expert = nrm(ks[27], (DEPTH, D_MODEL, N_EXPERTS), D_MODEL ** -0.5)
    b_router_expert = nrm(ks[28], (DEPTH, N_EXPERTS), 0.01)
    w_e_gate = nrm(ks[29], (DEPTH, N_EXPERTS, D_MODEL, EXPERT_FF), D_MODEL ** -0.5)
    w_e_up = nrm(ks[30], (DEPTH, N_EXPERTS, D_MODEL, EXPERT_FF), D_MODEL ** -0.5)
    w_e_down = nrm(ks[31], (DEPTH, N_EXPERTS, EXPERT_FF, D_MODEL), EXPERT_FF ** -0.5)
    norm_final_w = 1.0 + nrm(ks[32], (D_MODEL,), 0.02)
    return {'x': x, 'norm_mix_w': norm_mix_w, 'w_in': w_in, 'b_gate': b_gate,
            's5_lam_re': s5_lam_re, 's5_lam_im': s5_lam_im, 's5_log_step': s5_log_step,
            's5_b_re': s5_b_re, 's5_b_im': s5_b_im, 's5_c_re': s5_c_re, 's5_c_im': s5_c_im,
            's5_d': s5_d, 's5_w_glu': s5_w_glu, 's5_b_glu': s5_b_glu,
            'lru_conv_w': lru_conv_w, 'lru_conv_b': lru_conv_b, 'lru_w_a': lru_w_a, 'lru_b_a': lru_b_a,
            'lru_w_x': lru_w_x, 'lru_b_x': lru_b_x, 'lru_lambda': lru_lambda,
            'w_proj_s5': w_proj_s5, 'w_proj_lru': w_proj_lru, 'w_out': w_out,
            'norm_ffn_w': norm_ffn_w, 'w_router_group': w_router_group, 'b_router_group': b_router_group,
            'w_router_expert': w_router_expert, 'b_router_expert': b_router_expert,
            'w_e_gate': w_e_gate, 'w_e_up': w_e_up, 'w_e_down': w_e_down, 'norm_final_w': norm_final_w}


def reference(x, norm_mix_w, w_in, b_gate, s5_lam_re, s5_lam_im, s5_log_step, s5_b_re, s5_b_im,
              s5_c_re, s5_c_im, s5_d, s5_w_glu, s5_b_glu, lru_conv_w, lru_conv_b, lru_w_a, lru_b_a,
              lru_w_x, lru_b_x, lru_lambda, w_proj_s5, w_proj_lru, w_out, norm_ffn_w,
              w_router_group, b_router_group, w_router_expert, b_router_expert,
              w_e_gate, w_e_up, w_e_down, norm_final_w):
    for i in range(DEPTH):
        x = mixer_sublayer(x, norm_mix_w[i], w_in[i], b_gate[i], s5_lam_re[i], s5_lam_im[i],
                           s5_log_step[i], s5_b_re[i], s5_b_im[i], s5_c_re[i], s5_c_im[i], s5_d[i],
                           s5_w_glu[i], s5_b_glu[i], lru_conv_w[i], lru_conv_b[i], lru_w_a[i],
                           lru_b_a[i], lru_w_x[i], lru_b_x[i], lru_lambda[i], w_proj_s5[i],
                           w_proj_lru[i], w_out[i])
        x = moe_sublayer(x, norm_ffn_w[i], w_router_group[i], b_router_group[i],
                         w_router_expert[i], b_router_expert[i], w_e_gate[i], w_e_up[i], w_e_down[i])
    return rms_norm(x, norm_final_w)
```

```cpp
#include <hip/hip_runtime.h>
#include <stdint.h>
#include <stdio.h>

constexpr int T = 16384, D = 2048;
constexpr int S5W = 512, S5G = 32, S5GS = 16, S5P = 64;
constexpr int LW = 1536, LH = 12, LHD = 128;
constexpr int INC = 7680;
constexpr int NE = 32, EFF = 256;
constexpr float EPS = 1e-6f;

typedef unsigned short bf16;
#define LAS __attribute__((address_space(3)))
#define GAS __attribute__((address_space(1)))
typedef short bf16x8 __attribute__((ext_vector_type(8)));
typedef float f32x4 __attribute__((ext_vector_type(4)));
typedef float f32x2 __attribute__((ext_vector_type(2)));
typedef float f32x16 __attribute__((ext_vector_type(16)));
typedef unsigned u32x4 __attribute__((ext_vector_type(4)));
typedef unsigned u32x2 __attribute__((ext_vector_type(2)));
typedef int i32x8 __attribute__((ext_vector_type(8)));
typedef int i32x4 __attribute__((ext_vector_type(4)));

__device__ __forceinline__ float bf2f(bf16 v) { return __uint_as_float(((unsigned)v) << 16); }
__device__ __forceinline__ bf16 f2bf(float f) { unsigned u = __float_as_uint(f); return (bf16)((u + 0x7fffu + ((u >> 16) & 1u)) >> 16); }
__device__ __forceinline__ unsigned pk2(float lo, float hi) { return (unsigned)f2bf(lo) | ((unsigned)f2bf(hi) << 16); }
__device__ __forceinline__ unsigned cvt_pk_bf16(float lo, float hi) { unsigned r; asm volatile("v_cvt_pk_bf16_f32 %0, %1, %2" : "=v"(r) : "v"(lo), "v"(hi)); return r; }
__device__ __forceinline__ float sigmoidf_(float v) { return 1.f / (1.f + __expf(-v)); }
__device__ __forceinline__ float gelu_tanh(float v) { const float u = 0.7978845608028654f * (v + 0.044715f * v * v * v); return 0.5f * v * (1.f + tanhf(u)); }
#define F8PK(a, b, old, hi) __builtin_amdgcn_cvt_pk_fp8_f32(__builtin_amdgcn_fmed3f((a), -448.f, 448.f), __builtin_amdgcn_fmed3f((b), -448.f, 448.f), (old), (hi))
__device__ __forceinline__ float fsig(float v) { return __builtin_amdgcn_rcpf(1.f + __builtin_amdgcn_exp2f(-1.4426950408889634f * v)); }
__device__ __forceinline__ float fgelu(float v) { const float u2 = 1.5957691216057308f * (v + 0.044715f * v * v * v); return v * fsig(u2); }

constexpr int LC = 32, NCH = T / LC;
constexpr int S5KU = LC * 16, S5KT = S5KU + 128;
constexpr int LTT = 64, LNT = T / LTT;
constexpr size_t MiB = 1u << 20;
constexpr size_t WS_CTL   = 0, CTL_ZERO_BYTES = 1 * MiB;
constexpr size_t WS_RSTD1 = 1 * MiB;
constexpr size_t WS_LAML  = 1 * MiB + 128 * 1024;
constexpr size_t WS_WRH   = 1 * MiB + 256 * 1024;
constexpr size_t WS_WRL   = 1 * MiB + 384 * 1024;
constexpr size_t WS_WGH   = 1 * MiB + 512 * 1024;
constexpr size_t WS_WGL   = 1 * MiB + 640 * 1024;
constexpr size_t WS_WG    = 1 * MiB + 192 * 1024;
constexpr size_t WS_WR    = 1 * MiB + 768 * 1024;
constexpr size_t WS_WGLUT = 2 * MiB;
constexpr size_t WS_WLT   = 3 * MiB;
constexpr size_t WS_KTG   = 7 * MiB;
constexpr size_t WS_WG8   = 9 * MiB;
constexpr size_t WS_KTG_OLD = 8 * MiB + 512 * 1024;
constexpr size_t WS_AG    = 4 * MiB;
constexpr size_t WS_HIN   = 7 * MiB;
constexpr size_t WS_SEND  = 9 * MiB;
constexpr size_t WS_LISTI = 9 * MiB;
constexpr size_t WS_LISTR = 11 * MiB;
constexpr size_t WS_LISTW = 13 * MiB;
constexpr size_t WS_BTE   = 17 * MiB;
constexpr size_t WS_BTY   = 21 * MiB;
constexpr size_t WS_WPT   = 41 * MiB;
constexpr size_t WS_WOUTT = 49 * MiB;
constexpr size_t WS_WGUT  = 57 * MiB;
constexpr size_t WS_WDT   = 121 * MiB;
constexpr size_t WS_U5X   = 153 * MiB;
constexpr size_t WS_XL    = 173 * MiB;
constexpr size_t WS_GY    = 221 * MiB;
constexpr size_t WS_GATES = 269 * MiB;
constexpr size_t WS_XB    = 397 * MiB;
constexpr size_t WS_WINT  = 461 * MiB;
constexpr size_t WS_XF8   = 475 * MiB;
constexpr size_t WS_Y5    = 461 * MiB;
constexpr size_t WS_OUTC  = 477 * MiB;
constexpr size_t WS_X1B   = 173 * MiB;
constexpr size_t WS_OUTL  = 57 * MiB;
constexpr size_t WS_MERGED= 153 * MiB;
constexpr size_t WS_ACT   = 461 * MiB;
constexpr size_t WS_YS8   = 333 * MiB;
constexpr size_t WS_DELTA = 269 * MiB;
constexpr size_t WS_END   = 509 * MiB;

struct P {
    const float *x, *norm_mix_w, *w_in, *b_gate, *s5_lam_re, *s5_lam_im, *s5_log_step, *s5_b_re, *s5_b_im, *s5_c_re, *s5_c_im, *s5_d, *s5_w_glu, *s5_b_glu;
    const float *lru_conv_w, *lru_conv_b, *lru_w_a, *lru_b_a, *lru_w_x, *lru_b_x, *lru_lambda, *w_proj_s5, *w_proj_lru, *w_out, *norm_ffn_w;
    const float *w_rg, *b_rg, *w_re, *b_re, *w_e_gate, *w_e_up, *w_e_down, *norm_final_w;
    float* out; unsigned char* ws;
};

namespace pg8 {
constexpr int BM = 256, BK = 64, HALF = 128, HTB = HALF * BK * 2  , STAGE_BYTES = 8 * HTB, NXCD = 8, WGM = 8;
__host__ __device__ __forceinline__ int lds_byte(int r, int c) { const int st = (r >> 4) * 2 + (c >> 5), rr = r & 15, cc = c & 31, ob = rr * 64 + cc * 2; return st * 1024 + (ob ^ (((ob >> 9) & 1) << 5)); }
__host__ __device__ __forceinline__ void stage_rc(int b, int& R, int& C) { const int st = b / 1024, sb = b % 1024, swz = sb ^ (((sb >> 9) & 1) << 5); R = (st >> 1) * 16 + swz / 64; C = (st & 1) * 32 + (swz % 64) / 2; }
__host__ __device__ __forceinline__ int perm32(int rho) { const int n = rho >> 4, i = rho & 15; return 8 * (i >> 2) + 4 * n + (i & 3); }

struct Unit { int pm, pn; const char* A; const char* B; int nt; int aux, aux2, aux3, unit_i; };

struct PlainOrder {
    static constexpr bool GATHER = false;
    int nM, nN, nwg, G, c, nt; const char* A; const char* B; size_t astep, bstep;
    __device__ void init(int M, int N, int K, int lda, int ldb, const void* A_, const void* B_, int G_, int c_) {
        nM = M / BM; nN = N / BM; nwg = nM * nN; G = G_; c = c_; nt = K / BK; A = (const char*)A_; B = (const char*)B_; astep = (size_t)BM * lda * 2; bstep = (size_t)BM * ldb * 2; }
    __device__ bool next(int i, Unit& u) const { return next_L((long)i * G + c, u); }
    __device__ bool next_L(long L, Unit& u) const {
        if (L >= nwg) return false;
        int wgid = (int)L; { const int q = nwg / NXCD, r = nwg % NXCD, xcd = wgid % NXCD, off = wgid / NXCD; wgid = (xcd < r ? xcd * (q + 1) : r * (q + 1) + (xcd - r) * q) + off; }
        const int nig = WGM * nN, gid = wgid / nig, fm = gid * WGM, gsz = (nM - fm) < WGM ? (nM - fm) : WGM;
        u.pm = fm + ((wgid % nig) % gsz); u.pn = (wgid % nig) / gsz; u.A = A + (size_t)u.pm * astep; u.B = B + (size_t)u.pn * bstep; u.nt = nt; u.aux = 0; return true;
    }
    __device__ __forceinline__ void a_offsets(const Unit&, const int (&)[2], const int (&)[2], unsigned (&)[2][2]) const {}
    __device__ __forceinline__ void a_ready(const Unit&) const {}
    __device__ __forceinline__ void done(const Unit&) const {}
};

template <class Epi, class Sched, bool ALIGN_EPI, bool FP8 = false>
__device__ __forceinline__ void gemm_phase(LAS unsigned char* lds, const Sched& S, const Epi& E, int lda, int ldb) {
    const int tid = threadIdx.x, wid = __builtin_amdgcn_readfirstlane(tid >> 6), lane = tid & 63, wr = wid >> 2, wc = wid & 3, fr = lane & 15, fq = lane >> 4;
    unsigned voffAc[2][2], voffAn[2][2], voffB[2]; int Ra[2], Ca[2];
#pragma unroll
    for (int i = 0; i < 2; ++i) { int R, C; stage_rc(tid * 16 + i * 8192, R, C); const int Rb = Epi::PERM ? ((R & ~31) + perm32(R & 31)) : R;
        Ra[i] = R; Ca[i] = C * 2;
        voffAc[0][i] = (unsigned)(R * lda + C) * 2u; voffAc[1][i] = (unsigned)((R + HALF) * lda + C) * 2u; voffB[i] = (unsigned)(Rb * ldb + C) * 2u; }
    const size_t kstep = (size_t)(BK * 2);
    const size_t hstepB = (size_t)HALF * ldb * 2;
    const unsigned ldsw = (unsigned)wid * 1024u;
    const int aoff = lds_byte(wr * 64 + fr, fq * 8), boff = lds_byte(wc * 32 + fr, fq * 8);
#define PG8_SA(b, h) (((b) * 2 + (h)) * HTB)
#define PG8_SB(b, h) ((4 + (b) * 2 + (h)) * HTB)
#define PG8_STAGE2(bufoff, gbase, o0, o1) do { \
        __builtin_amdgcn_global_load_lds((const unsigned*)((const char*)(gbase) + (o0)), (LAS unsigned*)(lds + (bufoff) + ldsw), 16, 0, 0); \
        __builtin_amdgcn_global_load_lds((const unsigned*)((const char*)(gbase) + (o1)), (LAS unsigned*)(lds + (bufoff) + ldsw + 8192), 16, 0, 0); } while (0)
#define PG8_STAGE_B(bufoff, gbase) PG8_STAGE2(bufoff, gbase, voffB[0], voffB[1])
#define PG8_STAGE_AC(bufoff, gbase, h) PG8_STAGE2(bufoff, gbase, voffAc[h][0], voffAc[h][1])
#define PG8_STAGE_AX(bufoff, gbase, h) PG8_STAGE2(bufoff, gbase, (Sched::GATHER && last) ? voffAn[h][0] : voffAc[h][0], (Sched::GATHER && last) ? voffAn[h][1] : voffAc[h][1])
#define PG8_LD16(off) (*(const LAS i32x4*)(lds + (off)))
#define PG8_LDA(dst, b, h) do { if constexpr (FP8) { _Pragma("unroll") for (int m = 0; m < 4; ++m) dst##8[m] = __builtin_shufflevector(PG8_LD16(PG8_SA(b, h) + aoff + m * 2048), PG8_LD16(PG8_SA(b, h) + aoff + m * 2048 + 1024), 0, 1, 2, 3, 4, 5, 6, 7); } \
        else { _Pragma("unroll") for (int m = 0; m < 4; ++m) _Pragma("unroll") for (int k = 0; k < 2; ++k) dst[m][k] = *(const LAS bf16x8*)(lds + PG8_SA(b, h) + aoff + m * 2048 + k * 1024); } } while (0)
#define PG8_LDB(dst, b, h) do { if constexpr (FP8) { _Pragma("unroll") for (int n = 0; n < 2; ++n) dst##8[n] = __builtin_shufflevector(PG8_LD16(PG8_SB(b, h) + boff + n * 2048), PG8_LD16(PG8_SB(b, h) + boff + n * 2048 + 1024), 0, 1, 2, 3, 4, 5, 6, 7); } \
        else { _Pragma("unroll") for (int n = 0; n < 2; ++n) _Pragma("unroll") for (int k = 0; k < 2; ++k) dst[n][k] = *(const LAS bf16x8*)(lds + PG8_SB(b, h) + boff + n * 2048 + k * 1024); } } while (0)
#define PG8_MMA(ai, bj, At, Bt) do { __builtin_amdgcn_s_setprio(1); \
        if constexpr (FP8) { _Pragma("unroll") for (int m = 0; m < 4; ++m) _Pragma("unroll") for (int n = 0; n < 2; ++n) \
            asm volatile("v_mfma_f32_16x16x128_f8f6f4 %0, %1, %2, %0" : "+v"(acc[ai][bj][m][n]) : "v"(Bt##8[n]), "v"(At##8[m])); } \
        else { _Pragma("unroll") for (int m = 0; m < 4; ++m) _Pragma("unroll") for (int n = 0; n < 2; ++n) _Pragma("unroll") for (int k = 0; k < 2; ++k) \
            acc[ai][bj][m][n] = __builtin_amdgcn_mfma_f32_16x16x32_bf16(Bt[n][k], At[m][k], acc[ai][bj][m][n], 0, 0, 0); } \
        __builtin_amdgcn_s_setprio(0); } while (0)
#define PG8_WAIT_V(n) asm volatile("s_waitcnt vmcnt(" #n ")" ::: "memory")
#define PG8_WAIT_L(n) asm volatile("s_waitcnt lgkmcnt(" #n ")" ::: "memory")
#define PG8_BAR __builtin_amdgcn_s_barrier()
#define PG8_SCHED __builtin_amdgcn_sched_barrier(0)
    Unit cur, nxt; int ui = 0;
    if (!S.next(0, cur)) return;
    if constexpr (Sched::GATHER) S.a_offsets(cur, Ra, Ca, voffAc);
    f32x4 acc[2][2][4][2];
#pragma unroll
    for (int a = 0; a < 2; ++a)
#pragma unroll
        for (int b = 0; b < 2; ++b)
#pragma unroll
            for (int m = 0; m < 4; ++m)
#pragma unroll
                for (int n = 0; n < 2; ++n) acc[a][b][m][n] = (f32x4){0.f, 0.f, 0.f, 0.f};
    if constexpr (FP8) {
#pragma unroll
        for (int a = 0; a < 2; ++a)
#pragma unroll
            for (int b = 0; b < 2; ++b)
#pragma unroll
                for (int m = 0; m < 4; ++m)
#pragma unroll
                    for (int n = 0; n < 2; ++n) asm volatile("" : "+v"(acc[a][b][m][n]));
        asm volatile("s_nop 4" ::: "memory"); }
    bf16x8 At[4][2], B0[2][2], B1[2][2];
    i32x8 At8[4], B08[2], B18[2];
    int f8scale = 0x7f7f7f7f;
    if constexpr (FP8) asm volatile("v_mov_b32 %0, 0x7f7f7f7f\n\ts_nop 4" : "=v"(f8scale));
    const char* cA = cur.A; const char* cB = cur.B;
    S.a_ready(cur);
    PG8_STAGE_B(PG8_SB(0, 0), cB); PG8_STAGE_B(PG8_SB(0, 1), cB + hstepB); PG8_STAGE_AC(PG8_SA(0, 0), cA, 0); PG8_STAGE_AC(PG8_SA(0, 1), cA, 1);
    if (wr == 1) PG8_BAR;
    PG8_WAIT_V(2); PG8_BAR;
    PG8_STAGE_B(PG8_SB(1, 0), cB + kstep); PG8_STAGE_AC(PG8_SA(1, 0), cA + kstep, 0); PG8_STAGE_B(PG8_SB(1, 1), cB + hstepB + kstep);
    PG8_WAIT_V(6); PG8_BAR;
    for (;;) {
        const bool has_next = S.next(ui + 1, nxt);
        const char* nA = has_next ? nxt.A : cA; const char* nB = has_next ? nxt.B : cB;
        if constexpr (Sched::GATHER) {
            if (has_next) S.a_offsets(nxt, Ra, Ca, voffAn);
            else { voffAn[0][0] = voffAc[0][0]; voffAn[0][1] = voffAc[0][1]; voffAn[1][0] = voffAc[1][0]; voffAn[1][1] = voffAc[1][1]; }
        }
        const int nt = cur.nt;
        for (int t = 0; t < nt; t += 2) {
            const bool last = (t == nt - 2);
            if (last && has_next) S.a_ready(nxt);
            const char* a1 = cA + (size_t)(t + 1) * kstep;
            const char* a2 = last ? nA : cA + (size_t)(t + 2) * kstep; const char* b2 = last ? nB : cB + (size_t)(t + 2) * kstep;
            const char* a3 = a2 + kstep; const char* b3 = b2 + kstep;
            PG8_LDB(B0, 0, 0); PG8_LDB(B1, 0, 1); PG8_SCHED; PG8_LDA(At, 0, 0); PG8_STAGE_AC(PG8_SA(1, 1), a1, 1);
            PG8_WAIT_V(8); PG8_WAIT_L(0); PG8_BAR; PG8_MMA(0, 0, At, B0); PG8_MMA(0, 1, At, B1); PG8_BAR; PG8_SCHED;
            PG8_LDA(At, 0, 1); PG8_STAGE_B(PG8_SB(0, 0), b2); PG8_STAGE_B(PG8_SB(0, 1), b2 + hstepB); PG8_STAGE_AX(PG8_SA(0, 0), a2, 0);
            PG8_WAIT_V(8); PG8_WAIT_L(0); PG8_BAR; PG8_MMA(1, 0, At, B0); PG8_MMA(1, 1, At, B1); PG8_BAR; PG8_SCHED;
            PG8_LDB(B0, 1, 0); PG8_LDB(B1, 1, 1); PG8_SCHED; PG8_LDA(At, 1, 0); PG8_STAGE_AX(PG8_SA(0, 1), a2, 1);
            PG8_WAIT_V(8); PG8_WAIT_L(0); PG8_BAR; PG8_MMA(0, 0, At, B0); PG8_MMA(0, 1, At, B1); PG8_BAR; PG8_SCHED;
            PG8_LDA(At, 1, 1); PG8_STAGE_B(PG8_SB(1, 0), b3); PG8_STAGE_B(PG8_SB(1, 1), b3 + hstepB); PG8_STAGE_AX(PG8_SA(1, 0), a3, 0);
            PG8_WAIT_V(8); PG8_WAIT_L(0); PG8_BAR; PG8_MMA(1, 0, At, B0); PG8_MMA(1, 1, At, B1); PG8_BAR; PG8_SCHED;
        }
        if constexpr (ALIGN_EPI) { if (wr == 0) PG8_BAR; }
        if constexpr (FP8) { __builtin_amdgcn_sched_barrier(0); asm volatile("s_nop 15\n\ts_nop 7" ::: "memory"); __builtin_amdgcn_sched_barrier(0); }
        E(acc, cur, wr, wc, fr, fq); S.done(cur);
        if (!has_next) break;
        if (!(Epi::KEEP && cur.aux == 0))
#pragma unroll
        for (int a = 0; a < 2; ++a)
#pragma unroll
            for (int b = 0; b < 2; ++b)
#pragma unroll
                for (int m = 0; m < 4; ++m)
#pragma unroll
                    for (int n = 0; n < 2; ++n) acc[a][b][m][n] = (f32x4){0.f, 0.f, 0.f, 0.f};
        if constexpr (FP8) {
#pragma unroll
            for (int a = 0; a < 2; ++a)
#pragma unroll
                for (int b = 0; b < 2; ++b)
#pragma unroll
                    for (int m = 0; m < 4; ++m)
#pragma unroll
                        for (int n = 0; n < 2; ++n) asm volatile("" : "+v"(acc[a][b][m][n]));
            asm volatile("s_nop 4" ::: "memory"); }
        cur = nxt; cA = nA; cB = nB; ++ui;
        if constexpr (Sched::GATHER) { voffAc[0][0] = voffAn[0][0]; voffAc[0][1] = voffAn[0][1]; voffAc[1][0] = voffAn[1][0]; voffAc[1][1] = voffAn[1][1]; }
        if constexpr (ALIGN_EPI) { if (wr == 1) PG8_BAR; }
    }
    PG8_WAIT_V(0);
    if constexpr (!ALIGN_EPI) { if (wr == 0) PG8_BAR; }
    PG8_BAR;
#undef PG8_SA
#undef PG8_SB
#undef PG8_STAGE2
#undef PG8_STAGE_B
#undef PG8_STAGE_AC
#undef PG8_STAGE_AX
#undef PG8_LDA
#undef PG8_LDB
#undef PG8_MMA
#undef PG8_LD16
#undef PG8_WAIT_V
#undef PG8_WAIT_L
#undef PG8_BAR
#undef PG8_SCHED
}
}

#define XB_TMO      128
#define XB_XCNT(j)  (256  + 64 * (j))
#define XB_XSUB(j)  (1280 + 64 * (j))
#define XB_XGEN(j)  (2304 + 64 * (j))
#define XB_TOP      3328
#define XB_TOPGEN   3392
#define XCD_BAR_WORDS 3456
#define XB_SPIN_CAP (1u << 18)
__device__ __forceinline__ unsigned xb_ld(unsigned* p)              { return __hip_atomic_load(p, __ATOMIC_RELAXED, __HIP_MEMORY_SCOPE_AGENT); }
__device__ __forceinline__ unsigned xb_add(unsigned* p, unsigned v) { return __hip_atomic_fetch_add(p, v, __ATOMIC_RELAXED, __HIP_MEMORY_SCOPE_AGENT); }
__device__ __forceinline__ unsigned xb_xcc_id() { return (unsigned)__builtin_amdgcn_s_getreg((3 << 11) | 20) & 0xFu; }
#define XB_SPIN(cond, bar) do { unsigned _sp = 0; while (cond) { __builtin_amdgcn_s_sleep(1); \
    if ((++_sp & 255u) == 0u) { if (xb_ld(&(bar)[XB_TMO])) break; if (_sp > XB_SPIN_CAP) { atomicAdd(&(bar)[XB_TMO], 1u); break; } } } } while (0)
struct XcdBarrier { unsigned* bar; unsigned x; volatile LAS unsigned* st; };
__device__ __forceinline__ XcdBarrier xcd_barrier_post(unsigned* bar, volatile LAS unsigned* st) {
    XcdBarrier b; b.bar = bar; b.x = xb_xcc_id(); b.st = st;
    if (threadIdx.x == 0) (void)xb_add(&bar[XB_XCNT(b.x)], 1u);
    return b;
}
__device__ __forceinline__ void xcd_barrier_complete(unsigned* bar, unsigned x, unsigned& nloc, unsigned& nx) {
    const unsigned G = gridDim.x * gridDim.y * gridDim.z;
    unsigned sum, cnt, mine, sp = 0u;
    for (;;) {
        sum = 0u; cnt = 0u; mine = 0u;
#pragma unroll
        for (unsigned j = 0; j < 16; ++j) { const unsigned c = xb_ld(&bar[XB_XCNT(j)]); sum += c; cnt += (c > 0u) ? 1u : 0u; mine = (j == x) ? c : mine; }
        if (sum == G) break;
        __builtin_amdgcn_s_sleep(1);
        if ((++sp & 255u) == 0u) { if (xb_ld(&bar[XB_TMO])) break; if (sp > XB_SPIN_CAP) { atomicAdd(&bar[XB_TMO], 1u); break; } }
    }
    nloc = mine > 0u ? mine : 1u; nx = cnt > 0u ? cnt : 1u;
}
__device__ __forceinline__ void xcd_barrier(const XcdBarrier& b) {
    asm volatile("s_waitcnt vmcnt(0)" ::: "memory");
    __syncthreads();
    if (threadIdx.x == 0) {
        unsigned* bar = b.bar;
        __builtin_amdgcn_s_waitcnt(0);
        unsigned nloc = b.st[0], nx = b.st[1];
        if (nloc == 0u) { xcd_barrier_complete(bar, b.x, nloc, nx); b.st[0] = nloc; b.st[1] = nx; }
        const unsigned old = xb_add(&bar[XB_XSUB(b.x)], 1u);
        const unsigned gen = old / nloc;
        if (old + 1u == (gen + 1u) * nloc) {
            __builtin_amdgcn_fence(__ATOMIC_RELEASE, "agent");
            asm volatile("s_waitcnt vmcnt(0)" ::: "memory");
            const unsigned og = xb_add(&bar[XB_TOP], 1u);
            const unsigned tg = og / nx;
            if (og + 1u == (tg + 1u) * nx) xb_add(&bar[XB_TOPGEN], 1u);
            else XB_SPIN(xb_ld(&bar[XB_TOPGEN]) == tg, bar);
            __builtin_amdgcn_fence(__ATOMIC_ACQUIRE, "agent");
            xb_add(&bar[XB_XGEN(b.x)], 1u);
            asm volatile("s_waitcnt vmcnt(0)" ::: "memory");
        } else {
            XB_SPIN(xb_ld(&bar[XB_XGEN(b.x)]) == gen, bar);
            __builtin_amdgcn_fence(__ATOMIC_ACQUIRE, "agent");
            asm volatile("s_waitcnt vmcnt(0)" ::: "memory");
        }
    }
    __syncthreads();
}

constexpr int NWAVES = 8;
constexpr int RING_OFF = 0, RING_BYTES = 131072;
constexpr int LDSCTL_OFF = RING_BYTES, MISC_OFF = LDSCTL_OFF + 320;
constexpr int LDS_BYTES = 147456;
constexpr int LRU_PRE_OFF = 132096, LRU_SG4_OFF = 119808;
constexpr int CW_BAR = 4096;

#define LDS_WAIT() asm volatile("s_waitcnt lgkmcnt(0)" ::: "memory")
#define VM_WAIT() asm volatile("s_waitcnt vmcnt(0)" ::: "memory")

struct Args { P p; int ph_lo, ph_hi, li, pad; };

__device__ __forceinline__ int lane_now() { int l; asm volatile("v_mbcnt_lo_u32_b32 %0, -1, 0\n\tv_mbcnt_hi_u32_b32 %0, -1, %0" : "=v"(l)); return l; }
__device__ __forceinline__ float wave_sum(float v) {
#pragma unroll
    for (int o = 1; o < 64; o <<= 1) v += __shfl_xor(v, o);
    return v;
}
__device__ __forceinline__ void x_ldrow(const float* x, int m, int lane, f32x4 (&v)[8]) {
    const GAS f32x4* xr = (const GAS f32x4*)(x + (size_t)m * D) + lane;
#pragma unroll
    for (int j = 0; j < 8; ++j) v[j] = xr[64 * j];
}
__device__ __forceinline__ void x_strow(bf16* XB, unsigned* XF8, float* rstd1, int m, int lane, const f32x4 (&v)[8]) {
    float s = 0.f;
#pragma unroll
    for (int j = 0; j < 8; ++j) s += (v[j].x * v[j].x + v[j].y * v[j].y) + (v[j].z * v[j].z + v[j].w * v[j].w);
    s = wave_sum(s);
    if (lane == 0) rstd1[m] = rsqrtf(s * (1.f / D) + EPS);
    GAS u32x2* o8 = (GAS u32x2*)(XB + (size_t)m * D) + lane;
#pragma unroll
    for (int j = 0; j < 8; ++j) { u32x2 w; w.x = cvt_pk_bf16(v[j].x, v[j].y); w.y = cvt_pk_bf16(v[j].z, v[j].w); o8[64 * j] = w; }
    GAS unsigned* o4 = (GAS unsigned*)(XF8 + (size_t)m * (D / 4)) + lane;
#pragma unroll
    for (int j = 0; j < 8; ++j) { unsigned w = 0; w = F8PK(v[j].x, v[j].y, w, false); w = F8PK(v[j].z, v[j].w, w, true); o4[64 * j] = w; }
}
struct TItem { const float* src; bf16* dst; const float* ks; int ldw, ldk; };
template <bool HAS_KS> __device__ __forceinline__ void t_load(const TItem& t, int lane, f32x4 (&v)[8], float (&kv)[8]) {
    const int r8 = lane >> 3, c8 = lane & 7;
#pragma unroll
    for (int i = 0; i < 8; ++i) { v[i] = *(const GAS f32x4*)(t.src + (size_t)(8 * i + r8) * t.ldw + 4 * c8); if (HAS_KS) kv[i] = t.ks[8 * i + r8]; else kv[i] = 1.f; }
}
template <bool F8 = false> __device__ __forceinline__ void t_store(const TItem& t, int lane, const f32x4 (&v)[8], const float (&kv)[8], LAS float* scr) {
    const int r8 = lane >> 3, c8 = lane & 7;
#pragma unroll
    for (int i = 0; i < 8; ++i) {
#pragma unroll
        for (int e = 0; e < 4; ++e) scr[(4 * c8 + e) * 65 + 8 * i + r8] = v[i][e] * kv[i]; }
    LDS_WAIT(); asm volatile("" ::: "memory");
#pragma unroll
    for (int j = 0; j < 4; ++j) { const int n = r8 + 8 * j; const LAS float* sp = scr + n * 65 + 8 * c8;
        if constexpr (F8) {
            u32x2 o; unsigned w = 0; w = F8PK(sp[0] * 64.f, sp[1] * 64.f, w, false); w = F8PK(sp[2] * 64.f, sp[3] * 64.f, w, true); o.x = w;
            w = 0; w = F8PK(sp[4] * 64.f, sp[5] * 64.f, w, false); w = F8PK(sp[6] * 64.f, sp[7] * 64.f, w, true); o.y = w;
            *(GAS u32x2*)((unsigned char*)t.dst + (size_t)n * t.ldk + 8 * c8) = o; }
        else {
        u32x4 o; o.x = cvt_pk_bf16(sp[0], sp[1]); o.y = cvt_pk_bf16(sp[2], sp[3]); o.z = cvt_pk_bf16(sp[4], sp[5]); o.w = cvt_pk_bf16(sp[6], sp[7]);
        *(GAS u32x4*)(t.dst + (size_t)n * t.ldk + 8 * c8) = o; } }
    LDS_WAIT(); asm volatile("" ::: "memory");
}
template <int KIND> struct TKind;
template <> struct TKind<0> { static constexpr int N = (D / 64) * (3584 / 32); static constexpr bool KS = true; };
template <> struct TKind<8> { static constexpr int N = (D / 64) * (4096 / 32); static constexpr bool KS = true; };
template <> struct TKind<1> { static constexpr int N = (S5W / 64) * (S5W / 32); static constexpr bool KS = false; };
template <> struct TKind<2> { static constexpr int N = LH * 2 * 8; static constexpr bool KS = false; };
template <> struct TKind<3> { static constexpr int N = (D / 64) * (D / 32); static constexpr bool KS = false; };
template <> struct TKind<4> { static constexpr int N = (D / 64) * (D / 32); static constexpr bool KS = false; };
template <> struct TKind<5> { static constexpr int N = NE * 256; static constexpr bool KS = true; };
template <> struct TKind<6> { static constexpr int N = NE * 256; static constexpr bool KS = true; };
template <> struct TKind<7> { static constexpr int N = NE * 256; static constexpr bool KS = false; };
template <int KIND> __device__ __forceinline__ void t_decode(const P& p, int it, TItem& t) {
    unsigned char* ws = p.ws;
    if constexpr (KIND == 8) { const int kb = it / 128, nb = it % 128; t.src = p.w_in + (size_t)(64 * kb) * INC + 3584 + 32 * nb; t.ldw = INC; t.dst = (bf16*)(ws + WS_WG8 + (size_t)(32 * nb) * D + 64 * kb); t.ldk = D; t.ks = p.norm_mix_w + 64 * kb; }
    if constexpr (KIND == 0) { const int kb = it / (3584 / 32), nb = it % (3584 / 32); t.src = p.w_in + (size_t)(64 * kb) * INC + 32 * nb; t.ldw = INC; t.dst = (bf16*)(ws + WS_WINT) + (size_t)(32 * nb) * D + 64 * kb; t.ldk = D; t.ks = p.norm_mix_w + 64 * kb; }
    if constexpr (KIND == 1) { const int kb = it / (S5W / 32), nb = it % (S5W / 32); t.src = p.s5_w_glu + (size_t)(64 * kb) * S5W + 32 * nb; t.ldw = S5W; t.dst = (bf16*)(ws + WS_WGLUT) + (size_t)(32 * nb) * S5W + 64 * kb; t.ldk = S5W; t.ks = nullptr; }
    if constexpr (KIND == 2) { const int hg = it >> 3, sub = it & 7, hh = hg >> 1, gt = hg & 1, kb = sub >> 2, nb = sub & 3;
        const float* wa_ = p.lru_w_a; const float* wx_ = p.lru_w_x; asm volatile("" : "+s"(wa_), "+s"(wx_));
        t.src = (gt ? wx_ : wa_) + (size_t)hh * 128 * 128 + (size_t)(64 * kb) * 128 + 32 * nb; t.ldw = 128;
        t.dst = (bf16*)(ws + WS_WLT) + (size_t)(hh * 256 + gt * 128 + 32 * nb) * 128 + 64 * kb; t.ldk = 128; t.ks = nullptr; }
    if constexpr (KIND == 3) { const int kb = it / (D / 32), nb = it % (D / 32); t.ldw = D; t.ldk = D; t.ks = nullptr;
        const float* w5_ = p.w_proj_s5; const float* wl_ = p.w_proj_lru - (size_t)S5W * D; asm volatile("" : "+s"(w5_), "+s"(wl_));
        t.src = (kb < S5W / 64 ? w5_ : wl_) + (size_t)(64 * kb) * D + 32 * nb; t.dst = (bf16*)(ws + WS_WPT + (size_t)(32 * nb) * D + 64 * kb); }
    if constexpr (KIND == 4) { const int kb = it / (D / 32), nb = it % (D / 32); t.ldw = D; t.ldk = D; t.ks = nullptr;
        t.src = p.w_out + (size_t)(64 * kb) * D + 32 * nb; t.dst = (bf16*)(ws + WS_WOUTT + (size_t)(32 * nb) * D + 64 * kb); }
    if constexpr (KIND == 5 || KIND == 6) { const int e = it >> 8, q = it & 255, kb = q >> 3, nb = q & 7, n0 = 32 * nb;
        t.src = (KIND == 6 ? p.w_e_up : p.w_e_gate) + (size_t)e * D * EFF + (size_t)(64 * kb) * EFF + n0; t.ldw = EFF;
        t.dst = (bf16*)(ws + WS_WGUT + (size_t)(e * 512 + (n0 >> 7) * 256 + (KIND == 6 ? 128 : 0) + (n0 & 127)) * D + 64 * kb); t.ldk = D; t.ks = p.norm_ffn_w + 64 * kb; }
    if constexpr (KIND == 7) { const int e = it >> 8, q = it & 255, kb = q >> 6, nb = q & 63;
        t.src = p.w_e_down + (size_t)e * EFF * D + (size_t)(64 * kb) * D + 32 * nb; t.ldw = D;
        t.dst = (bf16*)(ws + WS_WDT) + (size_t)(e * D + 32 * nb) * EFF + 64 * kb; t.ldk = EFF; t.ks = nullptr; }
}
template <int KIND> __device__ __forceinline__ void t_ld(const P& p, int it, int lane, f32x4 (&v)[8], float (&kv)[8]) { TItem t; t_decode<KIND>(p, it, t); t_load<TKind<KIND>::KS>(t, lane, v, kv); }
template <int KIND> __device__ __forceinline__ void t_st(const P& p, int it, int lane, const f32x4 (&v)[8], const float (&kv)[8], LAS float* scr) { TItem t; t_decode<KIND>(p, it, t); t_store<KIND == 8 || KIND == 5 || KIND == 6 || KIND == 4 || KIND == 3>(t, lane, v, kv, scr); }
template <int KIND> __device__ __forceinline__ void t_run(const P& p, int first, int stride, int lane, LAS float* scr, int lo = 0, int hi = TKind<KIND>::N) {
    const int N = hi;
    f32x4 va[8], vb[8]; float ka[8], kb[8];
    int it = lo + first; if (it >= N) return;
    t_ld<KIND>(p, it, lane, va, ka);
    for (;;) {
        const bool hb = it + stride < N;
        if (hb) t_ld<KIND>(p, it + stride, lane, vb, kb);
        t_st<KIND>(p, it, lane, va, ka, scr);
        if (!hb) break;
        it += stride;
        const bool ha = it + stride < N;
        if (ha) t_ld<KIND>(p, it + stride, lane, va, ka);
        t_st<KIND>(p, it, lane, vb, kb, scr);
        if (!ha) break;
        it += stride;
    }
}

__device__ __forceinline__ void unpack8(const u32x4 w, f32x4& a, f32x4& b) {
    a[0] = __uint_as_float(w.x << 16); a[1] = __uint_as_float(w.x & 0xffff0000u); a[2] = __uint_as_float(w.y << 16); a[3] = __uint_as_float(w.y & 0xffff0000u);
    b[0] = __uint_as_float(w.z << 16); b[1] = __uint_as_float(w.z & 0xffff0000u); b[2] = __uint_as_float(w.w << 16); b[3] = __uint_as_float(w.w & 0xffff0000u); }
__device__ __forceinline__ void unpack8u(const u32x2 w, f32x4& a, f32x4& b) {
    a[0] = (float)(w.x & 0xffu); a[1] = (float)((w.x >> 8) & 0xffu); a[2] = (float)((w.x >> 16) & 0xffu); a[3] = (float)(w.x >> 24);
    b[0] = (float)(w.y & 0xffu); b[1] = (float)((w.y >> 8) & 0xffu); b[2] = (float)((w.y >> 16) & 0xffu); b[3] = (float)(w.y >> 24); }
__device__ __forceinline__ void st16_wt(void* p, u32x4 v) { asm volatile("global_store_dwordx4 %0, %1, off sc1\n\ts_nop 1" :: "v"(p), "v"(v) : "memory"); }
constexpr float GSC = 254.49f;
struct EpiInproj {
    static constexpr bool PERM = true; static constexpr bool KEEP = false;
    const float* rstd; const float* b_gate; bf16* U5; bf16* XL; bf16* GY; bf16* GATES;
    __device__ __forceinline__ void operator()(const f32x4 (&acc)[2][2][4][2], const pg8::Unit& u, int wr, int wc, int fr, int fq) const {
        const int row0 = u.pm * 256 + wr * 64 + fr, pn = u.pn, colb = wc * 32 + 8 * fq;
        f32x4 bv[2][2];
#pragma unroll
        for (int bj = 0; bj < 2; ++bj)
#pragma unroll
            for (int n = 0; n < 2; ++n) bv[bj][n] = (pn >= 14) ? *(const f32x4*)(b_gate + (pn * 256 + bj * 128 + colb - 3584) + 4 * n) * -1.4426950408889634f : (f32x4){0.f, 0.f, 0.f, 0.f};
#pragma unroll
        for (int ai = 0; ai < 2; ++ai)
#pragma unroll
            for (int m = 0; m < 4; ++m) {
                const int row = row0 + ai * 128 + m * 16; const float rs = rstd[row] * ((pn >= 14) ? (1.f / 64.f) : 1.f);
#pragma unroll
                for (int bj = 0; bj < 2; ++bj) {
                    const int col = pn * 256 + bj * 128 + colb;
                    f32x4 v0 = acc[ai][bj][m][0] * rs, v1 = acc[ai][bj][m][1] * rs; bf16* dst;
                    if (pn < 2) { dst = U5 + ((size_t)(col >> 4) * NCH + (row >> 5)) * S5KT + (row & 31) * 16 + (col & 15); }
                    else if (pn < 8) { dst = XL + (size_t)row * LW + (col - 512); }
                    else if (pn < 14) { dst = GY + (size_t)row * LW + (col - 2048);
#pragma unroll
                        for (int e = 0; e < 4; ++e) { v0[e] = fgelu(v0[e]); v1[e] = fgelu(v1[e]); } }
                    else {
                        const float nrs = rs * -1.4426950408889634f; u32x2 wq; wq.x = 0u; wq.y = 0u;
#pragma unroll
                        for (int e = 0; e < 4; ++e) {
                            const float g0 = __builtin_amdgcn_rcpf(1.f + __builtin_amdgcn_exp2f(__builtin_fmaf(acc[ai][bj][m][0][e], nrs, bv[bj][0][e])));
                            const float g1 = __builtin_amdgcn_rcpf(1.f + __builtin_amdgcn_exp2f(__builtin_fmaf(acc[ai][bj][m][1][e], nrs, bv[bj][1][e])));
                            wq.x = __builtin_amdgcn_cvt_pk_u8_f32(fmaxf(__builtin_fmaf(g0, GSC, 0.5f), 1.f), e, wq.x); wq.y = __builtin_amdgcn_cvt_pk_u8_f32(fmaxf(__builtin_fmaf(g1, GSC, 0.5f), 1.f), e, wq.y); }
                        *(u32x2*)((unsigned char*)GATES + (size_t)row * 4096 + (col - 3584)) = wq; continue; }
                    u32x4 w; w.x = cvt_pk_bf16(v0[0], v0[1]); w.y = cvt_pk_bf16(v0[2], v0[3]); w.z = cvt_pk_bf16(v1[0], v1[1]); w.w = cvt_pk_bf16(v1[2], v1[3]);
                    *(u32x4*)dst = w;
                }
            }
    }
};


struct Fp8Order {
    static constexpr bool GATHER = false;
    pg8::PlainOrder po; int w0, wstep, wn;
    __device__ bool next(int i, pg8::Unit& u) const { if (i >= wn || !po.next_L(w0 + i * wstep, u)) return false; u.pn += 14; return true; }
    __device__ __forceinline__ void a_offsets(const pg8::Unit&, const int (&)[2], const int (&)[2], unsigned (&)[2][2]) const {}
    __device__ __forceinline__ void a_ready(const pg8::Unit&) const {}
    __device__ __forceinline__ void done(const pg8::Unit&) const {}
};

struct S5EOrder {
    static constexpr bool GATHER = false;
    int G, c, lim; const char* A; const char* B;
    __device__ bool next(int i, pg8::Unit& u) const {
        const int L = i * G + c; if (L >= lim) return false;
        const int g = L >> 1; u.pm = L & 1; u.pn = 0; u.aux = g; u.nt = S5KU / 64;
        u.A = A + ((size_t)(g * NCH + 256 * u.pm) * S5KT) * 2; u.B = B + (size_t)g * 128 * S5KU * 2; return true; }
    __device__ __forceinline__ void a_offsets(const pg8::Unit&, const int (&)[2], const int (&)[2], unsigned (&)[2][2]) const {}
    __device__ __forceinline__ void a_ready(const pg8::Unit&) const {}
    __device__ __forceinline__ void done(const pg8::Unit&) const {}
};
struct EpiS5E {
    static constexpr bool PERM = false; static constexpr bool KEEP = false;
    float* SEND;
    __device__ __forceinline__ void operator()(const f32x4 (&acc)[2][2][4][2], const pg8::Unit& u, int wr, int wc, int fr, int fq) const {
        const int row0 = u.pm * 256 + wr * 64 + fr, col0 = wc * 32 + 4 * fq;
#pragma unroll
        for (int ai = 0; ai < 2; ++ai)
#pragma unroll
            for (int m = 0; m < 4; ++m) { float* rp = SEND + ((size_t)u.aux * NCH + row0 + ai * 128 + m * 16) * 128 + col0;
#pragma unroll
                for (int n = 0; n < 2; ++n) *(f32x4*)(rp + n * 16) = acc[ai][0][m][n]; }
    }
};
struct S5COrder {
    static constexpr bool GATHER = false;
    int G, c, lim; const char* A; const char* B;
    __device__ bool next(int i, pg8::Unit& u) const {
        const int L = i * G + c; if (L >= lim) return false;
        const int g = L >> 2; u.pm = (L >> 1) & 1; u.pn = L & 1; u.aux = g; u.nt = S5KT / 64;
        u.A = A + ((size_t)(g * NCH + 256 * u.pm) * S5KT) * 2; u.B = B + ((size_t)(g * S5KU + 256 * u.pn) * S5KT) * 2; return true; }
    __device__ __forceinline__ void a_offsets(const pg8::Unit&, const int (&)[2], const int (&)[2], unsigned (&)[2][2]) const {}
    __device__ __forceinline__ void a_ready(const pg8::Unit&) const {}
    __device__ __forceinline__ void done(const pg8::Unit&) const {}
};
struct EpiS5C {
    static constexpr bool PERM = true; static constexpr bool KEEP = false;
    const bf16* U5X; const float* dskip; bf16* Y5;
    __device__ __forceinline__ void operator()(const f32x4 (&acc)[2][2][4][2], const pg8::Unit& u, int wr, int wc, int fr, int fq) const {
        const int g = u.aux, row0 = u.pm * 256 + wr * 64 + fr, colb = u.pn * 256 + wc * 32 + 8 * fq;
#pragma unroll
        for (int bj = 0; bj < 2; ++bj) {
            const int n0 = colb + bj * 128, ti = n0 >> 4, c0 = n0 & 15;
            const f32x4 d0 = *(const f32x4*)(dskip + g * 16 + c0), d1 = *(const f32x4*)(dskip + g * 16 + c0 + 4);
            u32x4 uw[2][4];
#pragma unroll
            for (int ai = 0; ai < 2; ++ai)
#pragma unroll
                for (int m = 0; m < 4; ++m) uw[ai][m] = *(const u32x4*)(U5X + ((size_t)g * NCH + row0 + ai * 128 + m * 16) * S5KT + n0);
#pragma unroll
            for (int ai = 0; ai < 2; ++ai)
#pragma unroll
                for (int m = 0; m < 4; ++m) {
                    const int j = row0 + ai * 128 + m * 16;
                    f32x4 u0, u1; unpack8(uw[ai][m], u0, u1);
                    f32x4 v0 = acc[ai][bj][m][0] + d0 * u0, v1 = acc[ai][bj][m][1] + d1 * u1;
#pragma unroll
                    for (int e = 0; e < 4; ++e) { v0[e] = fgelu(v0[e]); v1[e] = fgelu(v1[e]); }
                    u32x4 w; w.x = cvt_pk_bf16(v0[0], v0[1]); w.y = cvt_pk_bf16(v0[2], v0[3]); w.z = cvt_pk_bf16(v1[0], v1[1]); w.w = cvt_pk_bf16(v1[2], v1[3]);
                    *(u32x4*)(Y5 + (size_t)(j * LC + ti) * S5W + g * 16 + c0) = w;
                }
            asm volatile("" ::: "memory");
        }
    }
};
struct EpiGlu {
    static constexpr bool PERM = true; static constexpr bool KEEP = false;
    const bf16* Y5; const float* bias; bf16* OUTC;
    __device__ __forceinline__ void operator()(const f32x4 (&acc)[2][2][4][2], const pg8::Unit& u, int wr, int wc, int fr, int fq) const {
        const int row0 = u.pm * 256 + wr * 64 + fr, colb = u.pn * 256 + wc * 32 + 8 * fq;
#pragma unroll
        for (int bj = 0; bj < 2; ++bj) {
            const int col = colb + bj * 128;
            const f32x4 b0 = *(const f32x4*)(bias + col), b1 = *(const f32x4*)(bias + col + 4);
            u32x4 yw[2][4];
#pragma unroll
            for (int ai = 0; ai < 2; ++ai)
#pragma unroll
                for (int m = 0; m < 4; ++m) yw[ai][m] = *(const u32x4*)(Y5 + (size_t)(row0 + ai * 128 + m * 16) * S5W + col);
#pragma unroll
            for (int ai = 0; ai < 2; ++ai)
#pragma unroll
                for (int m = 0; m < 4; ++m) {
                    f32x4 y0, y1; unpack8(yw[ai][m], y0, y1);
                    f32x4 v0 = acc[ai][bj][m][0] + b0, v1 = acc[ai][bj][m][1] + b1;
#pragma unroll
                    for (int e = 0; e < 4; ++e) { v0[e] = y0[e] * fsig(v0[e]); v1[e] = y1[e] * fsig(v1[e]); }
                    u32x2 w; { unsigned w_ = 0; w_ = F8PK(v0[0] * 16.f, v0[1] * 16.f, w_, false); w_ = F8PK(v0[2] * 16.f, v0[3] * 16.f, w_, true); w.x = w_; }
                    { unsigned w_ = 0; w_ = F8PK(v1[0] * 16.f, v1[1] * 16.f, w_, false); w_ = F8PK(v1[2] * 16.f, v1[3] * 16.f, w_, true); w.y = w_; }
                    *(u32x2*)((unsigned char*)OUTC + (size_t)(row0 + ai * 128 + m * 16) * D + col) = w;
                }
            asm volatile("" ::: "memory");
        }
    }
};

struct EpiProj {
    static constexpr bool PERM = true; static constexpr bool KEEP = true;
    const bf16* GATES; bf16* MERGED;
    __device__ __forceinline__ void operator()(f32x4 (&acc)[2][2][4][2], const pg8::Unit& u, int wr, int wc, int fr, int fq) const {
        const int row0 = u.pm * 256 + wr * 64 + fr, colb = u.pn * 256 + wc * 32 + 8 * fq;
        if (u.aux == 0) {
#pragma unroll
            for (int ai = 0; ai < 2; ++ai)
#pragma unroll
                for (int mh = 0; mh < 2; ++mh) {
                    u32x2 sw[2][2], lw[2][2];
#pragma unroll
                    for (int mm = 0; mm < 2; ++mm)
#pragma unroll
                        for (int bj = 0; bj < 2; ++bj) { const unsigned char* gp = (const unsigned char*)GATES + (size_t)(row0 + ai * 128 + (2 * mh + mm) * 16) * 4096 + colb + bj * 128; sw[mm][bj] = *(const u32x2*)gp; lw[mm][bj] = *(const u32x2*)(gp + 2048); }
#pragma unroll
                    for (int mm = 0; mm < 2; ++mm)
#pragma unroll
                        for (int bj = 0; bj < 2; ++bj) { const int m = 2 * mh + mm; f32x4 s0, s1, l0, l1; unpack8u(sw[mm][bj], s0, s1); unpack8u(lw[mm][bj], l0, l1);
#pragma unroll
                            for (int e = 0; e < 4; ++e) { acc[ai][bj][m][0][e] *= s0[e] * __builtin_amdgcn_rcpf(l0[e]); acc[ai][bj][m][1][e] *= s1[e] * __builtin_amdgcn_rcpf(l1[e]); } }
                    asm volatile("" ::: "memory"); }
            return; }
#pragma unroll
        for (int ai = 0; ai < 2; ++ai) {
            u32x2 lw[4][2];
#pragma unroll
            for (int m = 0; m < 4; ++m)
#pragma unroll
                for (int bj = 0; bj < 2; ++bj) lw[m][bj] = *(const u32x2*)((const unsigned char*)GATES + (size_t)(row0 + ai * 128 + m * 16) * 4096 + 2048 + colb + bj * 128);
#pragma unroll
            for (int m = 0; m < 4; ++m)
#pragma unroll
                for (int bj = 0; bj < 2; ++bj) { f32x4 l0, l1; unpack8u(lw[m][bj], l0, l1);
                    const f32x4 v0 = acc[ai][bj][m][0] * l0 * (1.f / (64.f * GSC)), v1 = acc[ai][bj][m][1] * l1 * (1.f / (64.f * GSC));
                    u32x2 w; { unsigned w_ = 0; w_ = F8PK(v0[0], v0[1], w_, false); w_ = F8PK(v0[2], v0[3], w_, true); w.x = w_; }
                    { unsigned w_ = 0; w_ = F8PK(v1[0], v1[1], w_, false); w_ = F8PK(v1[2], v1[3], w_, true); w.y = w_; }
                    *(u32x2*)((unsigned char*)MERGED + (size_t)(row0 + ai * 128 + m * 16) * D + colb + bj * 128) = w; }
            asm volatile("" ::: "memory"); }
    }
};
struct ProjOrder {
    static constexpr bool GATHER = false;
    pg8::PlainOrder po;
    __device__ bool next(int i, pg8::Unit& u) const {
        if (!po.next(i >> 1, u)) return false;
        if (i & 1) { u.A += S5W; u.B += S5W; u.nt = LW / 128; u.aux = 1; } else { u.nt = S5W / 128; u.aux = 0; }
        return true; }
    __device__ __forceinline__ void a_offsets(const pg8::Unit&, const int (&)[2], const int (&)[2], unsigned (&)[2][2]) const {}
    __device__ __forceinline__ void a_ready(const pg8::Unit&) const {}
    __device__ __forceinline__ void done(const pg8::Unit&) const {}
};
struct EpiWout {
    static constexpr bool PERM = true; static constexpr bool KEEP = false;
    bf16* DELTA; const bf16* XB;
    __device__ __forceinline__ void operator()(const f32x4 (&acc)[2][2][4][2], const pg8::Unit& u, int wr, int wc, int fr, int fq) const {
        const int row0 = u.pm * 256 + wr * 64 + fr, col0 = u.pn * 256 + wc * 32 + 8 * fq;
#pragma unroll
        for (int ai = 0; ai < 2; ++ai)
#pragma unroll
            for (int m = 0; m < 4; ++m)
#pragma unroll
                for (int bj = 0; bj < 2; ++bj) { f32x4 x0, x1; unpack8(*(const u32x4*)(XB + (size_t)(row0 + ai * 128 + m * 16) * D + col0 + bj * 128), x0, x1);
                    const f32x4 v0 = acc[ai][bj][m][0] * (1.f / 1024.f) + x0, v1 = acc[ai][bj][m][1] * (1.f / 1024.f) + x1;
                    u32x4 w; w.x = cvt_pk_bf16(v0[0], v0[1]); w.y = cvt_pk_bf16(v0[2], v0[3]); w.z = cvt_pk_bf16(v1[0], v1[1]); w.w = cvt_pk_bf16(v1[2], v1[3]);
                    *(u32x4*)(DELTA + (size_t)(row0 + ai * 128 + m * 16) * D + col0 + bj * 128) = w; }
    }
};

__device__ __forceinline__ void s5_tables(const P& p, LAS f32x2* LPW, LAS f32x2* CC, LAS f32x2* BB, int g, int tid) {
    const float step = expf(p.s5_log_step[g]);
#pragma unroll 1
    for (int e = tid; e < (LC + 1) * 64; e += 512) { const int d = e >> 6, pp = e & 63;
        const float lre = p.s5_lam_re[g * S5P + pp], lim = p.s5_lam_im[g * S5P + pp];
        const float er = expf((float)d * lre * step); float sn, cs; sincosf((float)d * lim * step, &sn, &cs);
        LPW[e] = (f32x2){er * cs, er * sn}; }
#pragma unroll 1
    for (int e = tid; e < 1024; e += 512) {
        {   const int pp = e >> 4, c = e & 15;
            const float lre = p.s5_lam_re[g * S5P + pp], lim = p.s5_lam_im[g * S5P + pp];
            const float er = expf(lre * step); float sn, cs; sincosf(lim * step, &sn, &cs);
            const float nr = er * cs - 1.f, ni = er * sn, den = lre * lre + lim * lim;
            const float cr = (nr * lre + ni * lim) / den, ci = (ni * lre - nr * lim) / den;
            const float br = p.s5_b_re[((size_t)g * S5P + pp) * 16 + c], bi = p.s5_b_im[((size_t)g * S5P + pp) * 16 + c];
            BB[e] = (f32x2){cr * br - ci * bi, cr * bi + ci * br}; }
        {   const int c = e >> 6, pp = e & 63;
            CC[e] = (f32x2){p.s5_c_re[((size_t)g * 16 + c) * S5P + pp], p.s5_c_im[((size_t)g * 16 + c) * S5P + pp]}; }
    }
    __syncthreads();
}
__device__ __forceinline__ void p0_s5_kt(const P& p, LAS unsigned char* lds, int g, int part, int tid) {
    LAS f32x2* LPW = (LAS f32x2*)lds; LAS f32x2* CC = LPW + (LC + 1) * 64; LAS f32x2* BB = CC + 16 * 64;
    s5_tables(p, LPW, CC, BB, g, tid);
    float* KTG = (float*)(p.ws + WS_KTG) + (size_t)g * LC * 256;
    for (int e = tid; e < 4 * 256; e += 512) { const int d = 4 * part + (e >> 8), c = (e >> 4) & 15, c2 = e & 15; float acc = 0.f;
#pragma unroll 4
        for (int pp = 0; pp < 64; ++pp) { const f32x2 cc = CC[c * 64 + pp], lp = LPW[d * 64 + pp], bb = BB[pp * 16 + c2];
            const float wr_ = cc.x * lp.x - cc.y * lp.y, wi_ = cc.x * lp.y + cc.y * lp.x;
            acc += wr_ * bb.x - wi_ * bb.y; }
        KTG[d * 256 + c * 16 + c2] = acc; }
    __syncthreads();
}
__device__ __forceinline__ void p0_s5_build(const P& p, LAS unsigned char* lds, int g, int part, int tid) {
    LAS f32x2* LPW = (LAS f32x2*)lds;
    LAS f32x2* CC  = LPW + (LC + 1) * 64;
    LAS f32x2* BB  = CC + 16 * 64;
    LAS float* KT  = (LAS float*)(BB + 64 * 16);
    {   const f32x4* KTG = (const f32x4*)((const float*)(p.ws + WS_KTG) + (size_t)g * LC * 256);
        for (int e = tid; e < LC * 64; e += 512) ((LAS f32x4*)KT)[e] = KTG[e]; }
    s5_tables(p, LPW, CC, BB, g, tid);
    const int wave = tid >> 6, lane = tid & 63;
    bf16* BtY = (bf16*)(p.ws + WS_BTY) + (size_t)g * S5KU * S5KT;
    for (int rr = 0; rr < 8; ++rr) {
        const int n = 64 * part + 8 * wave + rr, i = n >> 4, c = n & 15;
        for (int ch = lane; ch < S5KT / 8; ch += 64) {
            const int k0 = 8 * ch; float v[8];
            if (k0 < S5KU) { const int i2 = k0 >> 4, c0 = k0 & 15;
#pragma unroll
                for (int e = 0; e < 8; ++e) v[e] = (i2 <= i) ? KT[((i - i2) * 16 + c) * 16 + c0 + e] : 0.f; }
            else { const int q0 = k0 - S5KU; const bool im = q0 >= 64; const int p0 = q0 & 63;
#pragma unroll
                for (int e = 0; e < 8; ++e) { const f32x2 cc = CC[c * 64 + p0 + e], lp = LPW[(i + 1) * 64 + p0 + e];
                    v[e] = im ? -(cc.x * lp.y + cc.y * lp.x) : (cc.x * lp.x - cc.y * lp.y); } }
            u32x4 o; o.x = cvt_pk_bf16(v[0], v[1]); o.y = cvt_pk_bf16(v[2], v[3]); o.z = cvt_pk_bf16(v[4], v[5]); o.w = cvt_pk_bf16(v[6], v[7]);
            *(GAS u32x4*)(BtY + (size_t)n * S5KT + k0) = o;
        }
    }
    bf16* BtE = (bf16*)(p.ws + WS_BTE) + (size_t)g * 128 * S5KU;
    for (int rr = 0; rr < 2; ++rr) {
        const int r = 16 * part + 2 * wave + rr; const bool im = r >= 64; const int pp = r & 63;
        const int k0 = 8 * lane, i2 = k0 >> 4, c0 = k0 & 15; float v[8];
        const f32x2 lp = LPW[(LC - 1 - i2) * 64 + pp];
#pragma unroll
        for (int e = 0; e < 8; ++e) { const f32x2 bb = BB[pp * 16 + c0 + e]; v[e] = im ? (lp.x * bb.y + lp.y * bb.x) : (lp.x * bb.x - lp.y * bb.y); }
        u32x4 o; o.x = cvt_pk_bf16(v[0], v[1]); o.y = cvt_pk_bf16(v[2], v[3]); o.z = cvt_pk_bf16(v[4], v[5]); o.w = cvt_pk_bf16(v[6], v[7]);
        *(GAS u32x4*)(BtE + (size_t)r * S5KU + k0) = o;
    }
    if (part == 0 && tid < 64) ((f32x2*)(p.ws + WS_LAML))[g * 64 + tid] = LPW[LC * 64 + tid];
    __syncthreads();
}

template <int PASS, bool FUSED = false> __device__ __forceinline__ void lru_pass(const P& p, LAS unsigned char* lds, int G, int bx, int tid, int lane, int wave, int nbusy, int xtra) {
    const int h = bx % LH, q = bx / LH, nblk = (G - h + LH - 1) / LH, nq1 = (nbusy > h) ? ((nbusy - h + LH - 1) / LH < nblk ? (nbusy - h + LH - 1) / LH : nblk) : 0, n2 = nblk - nq1;
    const bool busy = q < nq1; const int R0 = xtra * n2;
#define LRU_TILE(k) (busy ? (R0 + (k) * nblk + q) : ((k) < xtra ? ((k) * n2 + (q - nq1)) : (R0 + ((k) - xtra) * nblk + q)))
    LAS float* RL = (LAS float*)lds; LAS float* IL = RL + LTT * 132;
    LAS bf16* XCB = (LAS bf16*)(lds + 3 * LTT * 128 * 4); LAS f32x2* SEG = (LAS f32x2*)(lds + 3 * LTT * 128 * 4 + LTT * 136 * 2);
    const bf16* XLg = (const bf16*)(p.ws + WS_XL); const bf16* GYg = (const bf16*)(p.ws + WS_GY); bf16* OC = (bf16*)(p.ws + WS_OUTC);
    const int j = tid & 127, s = tid >> 7, ch = h * LHD + j;
    const float cw0 = p.lru_conv_w[0 * LW + ch], cw1 = p.lru_conv_w[1 * LW + ch], cw2 = p.lru_conv_w[2 * LW + ch], cw3 = p.lru_conv_w[3 * LW + ch], cb = p.lru_conv_b[ch];
    const float nba = -1.4426950408889634f * p.lru_b_a[ch], nbx = -1.4426950408889634f * p.lru_b_x[ch];
    const float lam = p.lru_lambda[ch];
    const float sp8 = -8.f * 1.4426950408889634f * ((-lam > 20.f) ? -lam : log1pf(expf(-lam)));
    const int gate = wave >> 2, cb0 = (wave & 3) * 32, fr = lane & 15, fq = lane >> 4;
    const bf16* WL = (const bf16*)(p.ws + WS_WLT) + (size_t)h * 256 * 128;
    bf16x8 Bf[2][4];
#pragma unroll
    for (int nb = 0; nb < 2; ++nb)
#pragma unroll
        for (int ks = 0; ks < 4; ++ks) Bf[nb][ks] = *(const bf16x8*)(WL + (size_t)(gate * 128 + cb0 + 16 * nb + fr) * 128 + ks * 32 + 8 * fq);
    bf16 xs[19], xn[19], gs[16], gn[16]; float hin = 0.f, hinn = 0.f;
    const int kidx = LRU_TILE(0);
    if (kidx < LNT) { const int tb = kidx * LTT + 16 * s;
#pragma unroll
        for (int i = 0; i < 19; ++i) xs[i] = (tb - 3 + i >= 0) ? XLg[(size_t)(tb - 3 + i) * LW + ch] : (bf16)0;
        if (PASS == 1) {
#pragma unroll
            for (int i = 0; i < 16; ++i) gs[i] = GYg[(size_t)(tb + i) * LW + ch];
            if (!FUSED) hin = ((const float*)(p.ws + WS_HIN))[(size_t)kidx * LW + ch]; } }
    for (int kk = 0; ; ++kk) {
        const int tt = LRU_TILE(kk); if (tt >= LNT) break;
        const int t0 = tt * LTT, tb = t0 + 16 * s; const int tn = LRU_TILE(kk + 1);
        if (FUSED && PASS == 1) {
            const LAS f32x2* PRE = (const LAS f32x2*)(lds + LRU_PRE_OFF); const LAS f32x2* SG4 = (const LAS f32x2*)(lds + LRU_SG4_OFF);
            const f32x2 pr = PRE[kk * 128 + j]; const int qd = tt >> 6; float c = 0.f;
#pragma unroll
            for (int d = 0; d < 3; ++d) { const f32x2 sg = SG4[d * 128 + j]; if (d < qd) c = sg.x * c + sg.y; }
            hin = pr.x * c + pr.y; }
        float xcv[16];
        {
            float x0 = bf2f(xs[0]), x1 = bf2f(xs[1]), x2 = bf2f(xs[2]);
#pragma unroll
            for (int i = 0; i < 16; ++i) { const float x3 = bf2f(xs[3 + i]);
                const float xc = cb + cw0 * x0 + cw1 * x1 + cw2 * x2 + cw3 * x3; x0 = x1; x1 = x2; x2 = x3;
                xcv[i] = xc; XCB[(16 * s + i) * 136 + j] = (bf16)cvt_pk_bf16(xc, xc); }
        }
        if (tn < LNT) { const int tbn = tn * LTT + 16 * s;
#pragma unroll
            for (int i = 0; i < 19; ++i) xn[i] = XLg[(size_t)(tbn - 3 + i) * LW + ch];
            if (PASS == 1) {
#pragma unroll
                for (int i = 0; i < 16; ++i) gn[i] = GYg[(size_t)(tbn + i) * LW + ch];
                if (!FUSED) hinn = ((const float*)(p.ws + WS_HIN))[(size_t)tn * LW + ch]; } }
        __syncthreads();
        {
            f32x4 acc[4][2];
#pragma unroll
            for (int mb = 0; mb < 4; ++mb) { acc[mb][0] = (f32x4){0.f, 0.f, 0.f, 0.f}; acc[mb][1] = (f32x4){0.f, 0.f, 0.f, 0.f}; }
#pragma unroll
            for (int mb = 0; mb < 4; ++mb)
#pragma unroll
                for (int ks = 0; ks < 4; ++ks) { const bf16x8 a = *(const LAS bf16x8*)(XCB + (16 * mb + fr) * 136 + ks * 32 + 8 * fq);
                    acc[mb][0] = __builtin_amdgcn_mfma_f32_16x16x32_bf16(a, Bf[0][ks], acc[mb][0], 0, 0, 0);
                    acc[mb][1] = __builtin_amdgcn_mfma_f32_16x16x32_bf16(a, Bf[1][ks], acc[mb][1], 0, 0, 0); }
            LAS float* OL = gate ? IL : RL;
#pragma unroll
            for (int mb = 0; mb < 4; ++mb)
#pragma unroll
                for (int nb = 0; nb < 2; ++nb)
#pragma unroll
                    for (int r = 0; r < 4; ++r) OL[(16 * mb + 4 * fq + r) * 132 + cb0 + 16 * nb + fr] = acc[mb][nb][r];
        }
        __syncthreads();
        float av[16], bv[16]; float Ap = 1.f, Hp = 0.f;
        float zr[16], zi[16];
#pragma unroll
        for (int i = 0; i < 16; ++i) { zr[i] = RL[(16 * s + i) * 132 + j]; zi[i] = IL[(16 * s + i) * 132 + j]; }
        asm volatile("s_waitcnt lgkmcnt(0)" ::: "memory");
#pragma unroll
        for (int i = 0; i < 16; ++i) {
            const float r = __builtin_amdgcn_rcpf(1.f + __builtin_amdgcn_exp2f(__builtin_fmaf(zr[i], -1.4426950408889634f, nba)));
            const float ig = __builtin_amdgcn_rcpf(1.f + __builtin_amdgcn_exp2f(__builtin_fmaf(zi[i], -1.4426950408889634f, nbx)));
            const float a = __builtin_amdgcn_exp2f(sp8 * r);
            float mult = __builtin_amdgcn_sqrtf(__builtin_fmaf(-a, a, 1.f));
            if (i == 0) mult = (t0 + 16 * s == 0) ? 1.f : mult;
            const float bb = xcv[i] * ig * mult;
            av[i] = a; bv[i] = bb; Hp = a * Hp + bb; Ap *= a; }
        SEG[s * 128 + j] = (f32x2){Ap, Hp};
        __syncthreads();
        if (PASS == 0) {
            if (s == 0) { float A = 1.f, H = 0.f;
#pragma unroll
                for (int q = 0; q < 4; ++q) { const f32x2 sg = SEG[q * 128 + j]; H = sg.x * H + sg.y; A *= sg.x; }
                if (FUSED) __hip_atomic_store((unsigned long long*)(p.ws + WS_AG) + (size_t)tt * LW + ch, __builtin_bit_cast(unsigned long long, (f32x2){A, H}), __ATOMIC_RELAXED, __HIP_MEMORY_SCOPE_AGENT);
                else ((f32x2*)(p.ws + WS_AG))[(size_t)tt * LW + ch] = (f32x2){A, H}; }
        } else {
            float hc = hin;
#pragma unroll
            for (int q = 0; q < 3; ++q) { const f32x2 sg = SEG[q * 128 + j]; if (q < s) hc = sg.x * hc + sg.y; }
#pragma unroll
            for (int i = 0; i < 16; ++i) { hc = av[i] * hc + bv[i]; ((unsigned char*)OC)[(size_t)(tb + i) * D + S5W + ch] = (unsigned char)F8PK(hc * bf2f(gs[i]) * 16.f, 0.f, 0u, false); }
        }
#pragma unroll
        for (int i = 0; i < 19; ++i) xs[i] = xn[i];
        if (PASS == 1) {
#pragma unroll
            for (int i = 0; i < 16; ++i) gs[i] = gn[i];
            if (!FUSED) hin = hinn; }
    }
    __syncthreads();
#undef LRU_TILE
}

constexpr int CW_LH = 32768;
__device__ __forceinline__ void lru_mid(const P& p, LAS unsigned char* lds, unsigned* ctl, int li, int GL, int bl, int tid) {
    const int h = bl % LH, q = bl / LH, nblk = (GL - h + LH - 1) / LH;
    const int j = tid & 127, s = tid >> 7, ch = h * LHD + j;
    unsigned* cnt = ctl + CW_LH + li * 1024 + 64 * h;
    asm volatile("s_waitcnt vmcnt(0)" ::: "memory");
    if ((tid & 63) == 0) __hip_atomic_fetch_add(cnt, 1u, __ATOMIC_RELAXED, __HIP_MEMORY_SCOPE_AGENT);
    if (tid < 64) { unsigned sp = 0; const int want = nblk * NWAVES;
        while ((int)__builtin_amdgcn_readfirstlane(__hip_atomic_load(cnt, __ATOMIC_RELAXED, __HIP_MEMORY_SCOPE_AGENT)) < want) { __builtin_amdgcn_s_sleep(2); if (++sp > (1u << 22)) break; }
        __builtin_amdgcn_fence(__ATOMIC_ACQUIRE, "agent");
        asm volatile("s_waitcnt vmcnt(0)" ::: "memory"); }
    __syncthreads();
    LAS f32x2* PRE = (LAS f32x2*)(lds + LRU_PRE_OFF); LAS f32x2* SG4 = (LAS f32x2*)(lds + LRU_SG4_OFF);
    const f32x2* AGh = (const f32x2*)(p.ws + WS_AG) + (size_t)(64 * s) * LW + ch;
    int k = (64 * s <= q) ? 0 : (64 * s - q + nblk - 1) / nblk; int nxt = q + k * nblk - 64 * s;
    float A = 1.f, H = 0.f; f32x2 va[16], vb[16];
#pragma unroll
    for (int i = 0; i < 16; ++i) va[i] = AGh[(size_t)i * LW];
#pragma unroll
    for (int i = 0; i < 16; ++i) vb[i] = AGh[(size_t)(16 + i) * LW];
#pragma unroll
    for (int i = 0; i < 16; ++i) { if (i == nxt) { PRE[k * 128 + j] = (f32x2){A, H}; ++k; nxt += nblk; } H = va[i].x * H + va[i].y; A *= va[i].x; }
#pragma unroll
    for (int i = 0; i < 16; ++i) va[i] = AGh[(size_t)(32 + i) * LW];
#pragma unroll
    for (int i = 0; i < 16; ++i) { if (16 + i == nxt) { PRE[k * 128 + j] = (f32x2){A, H}; ++k; nxt += nblk; } H = vb[i].x * H + vb[i].y; A *= vb[i].x; }
#pragma unroll
    for (int i = 0; i < 16; ++i) vb[i] = AGh[(size_t)(48 + i) * LW];
#pragma unroll
    for (int i = 0; i < 16; ++i) { if (32 + i == nxt) { PRE[k * 128 + j] = (f32x2){A, H}; ++k; nxt += nblk; } H = va[i].x * H + va[i].y; A *= va[i].x; }
#pragma unroll
    for (int i = 0; i < 16; ++i) { if (48 + i == nxt) { PRE[k * 128 + j] = (f32x2){A, H}; ++k; nxt += nblk; } H = vb[i].x * H + vb[i].y; A *= vb[i].x; }
    SG4[s * 128 + j] = (f32x2){A, H};
    __syncthreads();
}

__device__ __forceinline__ void scan_lru(const P& p, int w, int lane) {
    const int ch = 64 * w + lane; const f32x2* AG = (const f32x2*)(p.ws + WS_AG); float* HIN = (float*)(p.ws + WS_HIN);
    float hc = 0.f; f32x2 a[8], b[8];
#pragma unroll
    for (int q = 0; q < 8; ++q) a[q] = AG[(size_t)q * LW + ch];
    for (int tt = 0; tt < LNT; tt += 16) {
#pragma unroll
        for (int q = 0; q < 8; ++q) b[q] = AG[(size_t)(tt + 8 + q) * LW + ch];
#pragma unroll
        for (int q = 0; q < 8; ++q) { HIN[(size_t)(tt + q) * LW + ch] = hc; hc = a[q].x * hc + a[q].y; }
        if (tt + 16 < LNT) {
#pragma unroll
            for (int q = 0; q < 8; ++q) a[q] = AG[(size_t)(tt + 16 + q) * LW + ch]; }
#pragma unroll
        for (int q = 0; q < 8; ++q) { HIN[(size_t)(tt + 8 + q) * LW + ch] = hc; hc = b[q].x * hc + b[q].y; }
    }
}
__device__ __forceinline__ void scan_s5(const P& p, int g, int lane) {
    const f32x2 lam = ((const f32x2*)(p.ws + WS_LAML))[g * 64 + lane];
    const float* SE = (const float*)(p.ws + WS_SEND) + (size_t)g * NCH * 128; bf16* UX = (bf16*)(p.ws + WS_U5X) + (size_t)g * NCH * S5KT;
    float sr = 0.f, si = 0.f; float er[8], ei[8], fr_[8], fi_[8];
#pragma unroll
    for (int q = 0; q < 8; ++q) { er[q] = SE[(size_t)q * 128 + lane]; ei[q] = SE[(size_t)q * 128 + 64 + lane]; }
    for (int jc = 0; jc < NCH; jc += 16) {
#pragma unroll
        for (int q = 0; q < 8; ++q) { fr_[q] = SE[(size_t)(jc + 8 + q) * 128 + lane]; fi_[q] = SE[(size_t)(jc + 8 + q) * 128 + 64 + lane]; }
#pragma unroll
        for (int q = 0; q < 8; ++q) { UX[(size_t)(jc + q) * S5KT + S5KU + lane] = f2bf(sr); UX[(size_t)(jc + q) * S5KT + S5KU + 64 + lane] = f2bf(si);
            const float nr = lam.x * sr - lam.y * si + er[q], ni = lam.x * si + lam.y * sr + ei[q]; sr = nr; si = ni; }
        if (jc + 16 < NCH) {
#pragma unroll
            for (int q = 0; q < 8; ++q) { er[q] = SE[(size_t)(jc + 16 + q) * 128 + lane]; ei[q] = SE[(size_t)(jc + 16 + q) * 128 + 64 + lane]; } }
#pragma unroll
        for (int q = 0; q < 8; ++q) { UX[(size_t)(jc + 8 + q) * S5KT + S5KU + lane] = f2bf(sr); UX[(size_t)(jc + 8 + q) * S5KT + S5KU + 64 + lane] = f2bf(si);
            const float nr = lam.x * sr - lam.y * si + fr_[q], ni = lam.x * si + lam.y * sr + fi_[q]; sr = nr; si = ni; }
    }
}


constexpr int CW_ECNT = 16384;
constexpr int ECNT_OFF = MISC_OFF + 128;
__device__ __forceinline__ void router_phase(const P& p, LAS unsigned char* lds, int G, int bx, int tid, int lane, int wave, bool dry) {
    LAS float* PL = (LAS float*)lds;
    LAS unsigned* HC = (LAS unsigned*)(lds + 8 * 32 * 40 * 4);
    const bf16* WRH = (const bf16*)(p.ws + WS_WRH); const bf16* WRL = (const bf16*)(p.ws + WS_WRL); const bf16* WGH = (const bf16*)(p.ws + WS_WGH); const bf16* WGL = (const bf16*)(p.ws + WS_WGL);
    unsigned* gcount = (unsigned*)(p.ws + WS_CTL) + CW_ECNT;
    int* LISTI = (int*)(p.ws + WS_LISTI); float* LISTR = (float*)(p.ws + WS_LISTR); float* LISTW = (float*)(p.ws + WS_LISTW);
    const int tt = wave >> 2, kq = wave & 3, i = lane & 31, kh = lane >> 5;
    const bf16x8 zero8 = (bf16x8){0, 0, 0, 0, 0, 0, 0, 0};
#define RT_LOAD(X, BH, BL, GH, GL, it_) do { X[0] = *(const u32x4*)(dl + (it_) * 32); X[1] = *(const u32x4*)(dl + (it_) * 32 + 8); \
        _Pragma("unroll") for (int u = 0; u < 2; ++u) { const size_t wo = ((size_t)(kq * 64 + (it_) * 4 + 2 * kh + u) * 32 + i) * 8; \
            BH[u] = *(const bf16x8*)(WRH + wo); BL[u] = *(const bf16x8*)(WRL + wo); GH[u] = zero8; GL[u] = zero8; \
            if (i < 4) { GH[u] = *(const bf16x8*)(WGH + wo); GL[u] = *(const bf16x8*)(WGL + wo); } } } while (0)
#define RT_STEP(XW, BH, BL, GH, GL, it_) do { \
        _Pragma("unroll") for (int u = 0; u < 2; ++u) { const bf16x8 a_ = __builtin_bit_cast(bf16x8, XW[u]); \
            acc = __builtin_amdgcn_mfma_f32_32x32x16_bf16(a_, BH[u], acc, 0, 0, 0); accg = __builtin_amdgcn_mfma_f32_32x32x16_bf16(a_, GH[u], accg, 0, 0, 0); \
            acc = __builtin_amdgcn_mfma_f32_32x32x16_bf16(a_, BL[u], acc, 0, 0, 0); accg = __builtin_amdgcn_mfma_f32_32x32x16_bf16(a_, GL[u], accg, 0, 0, 0); } \
        f32x4 X[4]; unpack8(XW[0], X[0], X[1]); unpack8(XW[1], X[2], X[3]); \
        { u32x4 w0; \
          { unsigned w_ = 0; w_ = F8PK(X[0][0], X[0][1], w_, false); w_ = F8PK(X[0][2], X[0][3], w_, true); w0.x = w_; } \
          { unsigned w_ = 0; w_ = F8PK(X[1][0], X[1][1], w_, false); w_ = F8PK(X[1][2], X[1][3], w_, true); w0.y = w_; } \
          { unsigned w_ = 0; w_ = F8PK(X[2][0], X[2][1], w_, false); w_ = F8PK(X[2][2], X[2][3], w_, true); w0.z = w_; } \
          { unsigned w_ = 0; w_ = F8PK(X[3][0], X[3][1], w_, false); w_ = F8PK(X[3][2], X[3][3], w_, true); w0.w = w_; } \
          if (!dry) *(u32x4*)(xb + (it_) * 32) = w0; } \
        _Pragma("unroll") for (int g4 = 0; g4 < 4; ++g4) _Pragma("unroll") for (int q = 0; q < 4; ++q) ss += X[g4][q] * X[g4][q]; } while (0)
    for (int tg = bx; tg < T / 64; tg += G) {
        if (tid < 32) HC[tid] = 0u;
        const size_t xoff = (size_t)(tg * 64 + tt * 32 + i) * D + kq * 512 + 16 * kh;
        const bf16* dl = (const bf16*)(p.ws + WS_DELTA) + xoff; unsigned char* xb = (unsigned char*)(p.ws + WS_X1B) + xoff;
        f32x16 acc;
#pragma unroll
        for (int r = 0; r < 16; ++r) acc[r] = 0.f;
        f32x16 accg;
#pragma unroll
        for (int r = 0; r < 16; ++r) accg[r] = 0.f;
        float ss = 0.f;
        u32x4 xA[2], xB[2]; bf16x8 hA[2], lA[2], ghA[2], glA[2], hB[2], lB[2], ghB[2], glB[2];
        RT_LOAD(xA, hA, lA, ghA, glA, 0);
#pragma unroll 1
        for (int it = 0; it < 16; it += 2) {
            RT_LOAD(xB, hB, lB, ghB, glB, it + 1);
            RT_STEP(xA, hA, lA, ghA, glA, it);
            if (it + 2 < 16) RT_LOAD(xA, hA, lA, ghA, glA, it + 2);
            RT_STEP(xB, hB, lB, ghB, glB, it + 1);
        }
#undef RT_LOAD
#undef RT_STEP
        ss += __shfl_xor(ss, 32);
        LAS float* pw = PL + wave * 32 * 40;
#pragma unroll
        for (int r = 0; r < 16; ++r) pw[((r & 3) + 8 * (r >> 2) + 4 * kh) * 40 + 4 + i] = acc[r];
        if (i < 4) {
#pragma unroll
            for (int r = 0; r < 16; ++r) pw[((r & 3) + 8 * (r >> 2) + 4 * kh) * 40 + i] = accg[r]; }
        if (kh == 0) pw[i * 40 + 36] = ss;
        __syncthreads();
        if (tid < 64) {
            const LAS float* q0 = PL + ((tid >> 5) * 4) * 32 * 40 + (tid & 31) * 40;
            float lg[37];
#pragma unroll
            for (int q = 0; q < 37; ++q) lg[q] = (q0[q] + q0[32 * 40 + q]) + (q0[2 * 32 * 40 + q] + q0[3 * 32 * 40 + q]);
            const float rstd = rsqrtf(lg[36] * (1.f / D) + EPS);
            float gmax = lg[0] * rstd + p.b_rg[0]; int gi = 0;
#pragma unroll
            for (int q = 1; q < 4; ++q) { const float v = lg[q] * rstd + p.b_rg[q]; if (v > gmax) { gmax = v; gi = q; } }
            float gs = 0.f;
#pragma unroll
            for (int q = 0; q < 4; ++q) gs += __expf(lg[q] * rstd + p.b_rg[q] - gmax);
            const float gtop = 1.f / gs;
            float m1 = -INFINITY, m2 = -INFINITY; int i1 = 0, i2 = 0;
#pragma unroll
            for (int e = 0; e < 32; ++e) { const float v = lg[4 + e] * rstd + p.b_re[e];
                if ((e >> 3) == gi) { if (v > m1) { m2 = m1; i2 = i1; m1 = v; i1 = e; } else if (v > m2) { m2 = v; i2 = e; } } }
            const float e2 = __expf(m2 - m1);
            const float w1 = gtop / (1.f + e2), w2 = gtop * e2 / (1.f + e2);
            if (!dry) {
            const unsigned r1 = atomicAdd((unsigned*)&HC[i1], 1u), r2 = atomicAdd((unsigned*)&HC[i2], 1u);
            asm volatile("s_waitcnt lgkmcnt(0)" ::: "memory");
            if (tid < 32) { const unsigned c = HC[tid]; HC[32 + tid] = c ? atomicAdd(&gcount[tid], c) : 0u; }
            asm volatile("s_waitcnt vmcnt(0) lgkmcnt(0)" ::: "memory");
            const unsigned s1 = HC[32 + i1] + r1, s2 = HC[32 + i2] + r2; const int tok = tg * 64 + tid;
            LISTI[(size_t)i1 * T + s1] = tok * 2;     LISTR[(size_t)i1 * T + s1] = rstd; LISTW[(size_t)i1 * T + s1] = w1;
            LISTI[(size_t)i2 * T + s2] = tok * 2 + 1; LISTR[(size_t)i2 * T + s2] = rstd; LISTW[(size_t)i2 * T + s2] = w2;
            } else if (w1 + w2 == 12345.f) LISTW[0] = w1;
        }
        __syncthreads();
    }
}
template <int NPN> __device__ __forceinline__ bool moe_find(const LAS unsigned* ecnt, int L, pg8::Unit& u) {
    int e = 0, tp = 0, cnt = 0, found = 0;
    for (int q = 0; q < NE; ++q) { const int c = (int)ecnt[q], n = ((c + 255) >> 8) * NPN; if (!found) { if (L < n) { found = 1; e = q; cnt = c; } else { L -= n; tp += (c + 255) >> 8; } } }
    if (!__builtin_amdgcn_readfirstlane(found)) return false;
    u.aux = __builtin_amdgcn_readfirstlane(e); u.aux2 = __builtin_amdgcn_readfirstlane(tp) * 256; u.aux3 = __builtin_amdgcn_readfirstlane(cnt);
    const int Lr = __builtin_amdgcn_readfirstlane(L); u.pm = Lr / NPN; u.pn = Lr % NPN; return true;
}
constexpr int CW_M9 = 16512;
struct MoeOrder1 {
    static constexpr bool GATHER = true;
    int G, c; const LAS unsigned* ecnt; const char* X1B; const char* W; const int* LISTI; unsigned* ctl; bool count;
    __device__ bool next(int i, pg8::Unit& u) const {
        if (!moe_find<2>(ecnt, i * G + c, u)) return false;
        u.A = X1B; u.B = W + ((size_t)u.aux * 512 + 256 * u.pn) * D; u.nt = D / 128; u.unit_i = i; return true; }
    __device__ __forceinline__ void a_offsets(const pg8::Unit& u, const int (&Ra)[2], const int (&Ca)[2], unsigned (&voff)[2][2]) const {
#pragma unroll
        for (int hh = 0; hh < 2; ++hh)
#pragma unroll
            for (int i = 0; i < 2; ++i) { int idx = u.pm * 256 + hh * 128 + Ra[i]; idx = idx < u.aux3 ? idx : 0;
                voff[hh][i] = (unsigned)(LISTI[(size_t)u.aux * T + idx] >> 1) * (unsigned)D + (unsigned)Ca[i]; }
    }
    __device__ __forceinline__ void a_ready(const pg8::Unit&) const {}
    __device__ __forceinline__ void done(const pg8::Unit& u) const {
        asm volatile("s_waitcnt vmcnt(0)" ::: "memory");
        if (count && (threadIdx.x & 63) == 0) __hip_atomic_fetch_add(ctl + CW_M9 + 64 * u.unit_i, 1u, __ATOMIC_RELAXED, __HIP_MEMORY_SCOPE_AGENT);
    }
};
struct EpiMoe1 {
    static constexpr bool PERM = true; static constexpr bool KEEP = false;
    const float* LISTR; const float* LISTW; bf16* ACT;
    __device__ __forceinline__ void operator()(const f32x4 (&acc)[2][2][4][2], const pg8::Unit& u, int wr, int wc, int fr, int fq) const {
        const int e = u.aux, cnt = u.aux3;
        float rsv[2][4], wv[2][4];
#pragma unroll
        for (int ai = 0; ai < 2; ++ai)
#pragma unroll
            for (int m = 0; m < 4; ++m) { const int idx = u.pm * 256 + ai * 128 + wr * 64 + m * 16 + fr; const bool valid = idx < cnt;
                rsv[ai][m] = valid ? LISTR[(size_t)e * T + idx] : 0.f; wv[ai][m] = valid ? LISTW[(size_t)e * T + idx] : 0.f; }
#pragma unroll
        for (int ai = 0; ai < 2; ++ai)
#pragma unroll
            for (int m = 0; m < 4; ++m) { const int idx = u.pm * 256 + ai * 128 + wr * 64 + m * 16 + fr; const bool valid = idx < cnt;
                const float rs = rsv[ai][m] * (1.f / 64.f), w = wv[ai][m];
                f32x4 a0, a1;
#pragma unroll
                for (int q = 0; q < 4; ++q) { const float g0 = acc[ai][0][m][0][q] * rs, g1 = acc[ai][0][m][1][q] * rs;
                    a0[q] = g0 * fsig(g0) * (acc[ai][1][m][0][q] * rs) * w; a1[q] = g1 * fsig(g1) * (acc[ai][1][m][1][q] * rs) * w; }
                u32x4 o; o.x = cvt_pk_bf16(a0[0], a0[1]); o.y = cvt_pk_bf16(a0[2], a0[3]); o.z = cvt_pk_bf16(a1[0], a1[1]); o.w = cvt_pk_bf16(a1[2], a1[3]);
                if (valid) { bf16* dp = ACT + (size_t)(u.aux2 + idx) * EFF + u.pn * 128 + wc * 32 + 8 * fq;
                    asm volatile("global_store_dwordx4 %0, %1, off sc1\n\ts_nop 1" :: "v"(dp), "v"(o) : "memory"); } }
    }
};
struct MoeOrder2 {
    static constexpr bool GATHER = false;
    const LAS unsigned* ecnt; const char* ACT; const char* W; int u0, ustep, ulim, imax;
    __device__ bool next(int i, pg8::Unit& u) const {
        const int L = u0 + i * ustep;
        if (i >= imax || L >= ulim || !moe_find<8>(ecnt, L, u)) return false;
        u.A = ACT + (size_t)(u.aux2 + 256 * u.pm) * EFF * 2; u.B = W + ((size_t)u.aux * D + 256 * u.pn) * EFF * 2; u.nt = EFF / 64; u.unit_i = i; return true; }
    __device__ __forceinline__ void a_offsets(const pg8::Unit&, const int (&)[2], const int (&)[2], unsigned (&)[2][2]) const {}
    __device__ __forceinline__ void a_ready(const pg8::Unit&) const {}
    __device__ __forceinline__ void done(const pg8::Unit&) const {}
};
__device__ __forceinline__ void moe_wait_round(unsigned* ctl, int r, int want) {
    if (threadIdx.x < 64) { unsigned sp = 0;
        while ((int)__builtin_amdgcn_readfirstlane(__hip_atomic_load(ctl + CW_M9 + 64 * r, __ATOMIC_RELAXED, __HIP_MEMORY_SCOPE_AGENT)) < want) { __builtin_amdgcn_s_sleep(2); if (++sp > (1u << 22)) break; }
        __builtin_amdgcn_fence(__ATOMIC_ACQUIRE, "agent");
        asm volatile("s_waitcnt vmcnt(0)" ::: "memory");
    }
    __syncthreads();
}
struct EpiMoe2 {
    static constexpr bool PERM = true; static constexpr bool KEEP = false;
    const int* LISTI; bf16* YS;
    __device__ __forceinline__ void operator()(const f32x4 (&acc)[2][2][4][2], const pg8::Unit& u, int wr, int wc, int fr, int fq) const {
        const int e = u.aux, cnt = u.aux3;
        int ent[2][4];
#pragma unroll
        for (int ai = 0; ai < 2; ++ai)
#pragma unroll
            for (int m = 0; m < 4; ++m) { const int idx = u.pm * 256 + ai * 128 + wr * 64 + m * 16 + fr; ent[ai][m] = (idx < cnt) ? LISTI[(size_t)e * T + idx] : -1; }
#pragma unroll
        for (int ai = 0; ai < 2; ++ai)
#pragma unroll
            for (int m = 0; m < 4; ++m) {
#pragma unroll
                for (int bj = 0; bj < 2; ++bj) { const f32x4 v0 = acc[ai][bj][m][0] * 64.f, v1 = acc[ai][bj][m][1] * 64.f;
                    u32x2 o; { unsigned w_ = 0; w_ = F8PK(v0[0], v0[1], w_, false); w_ = F8PK(v0[2], v0[3], w_, true); o.x = w_; }
                    { unsigned w_ = 0; w_ = F8PK(v1[0], v1[1], w_, false); w_ = F8PK(v1[2], v1[3], w_, true); o.y = w_; }
                    if (ent[ai][m] >= 0) *(u32x2*)((unsigned char*)YS + (size_t)ent[ai][m] * D + u.pn * 256 + bj * 128 + wc * 32 + 8 * fq) = o; } }
    }
};

__global__ void __launch_bounds__(NWAVES * 64, 2) mk_fwd(Args args) {
    extern __shared__ __attribute__((aligned(16))) unsigned char lds_raw[];
    LAS unsigned char* lds = (LAS unsigned char*)lds_raw;
    volatile LAS unsigned* MISC = (volatile LAS unsigned*)(lds + MISC_OFF);
    const P& p = args.p;
    const int tid = threadIdx.x, lane = tid & 63, wave = __builtin_amdgcn_readfirstlane(tid >> 6);
    const int G = gridDim.x; const int bx = blockIdx.x; const int vcu = (G % 8 == 0) ? (bx % 8) * (G / 8) + bx / 8 : bx;
    unsigned char* ws = p.ws;
    unsigned* ctl = (unsigned*)(ws + WS_CTL);
    for (int u = tid; u < (LDS_BYTES - LDSCTL_OFF) / 4; u += NWAVES * 64) ((LAS unsigned*)(lds + LDSCTL_OFF))[u] = 0u;
    __syncthreads();
    XcdBarrier bar = xcd_barrier_post(ctl + CW_BAR + args.li * XCD_BAR_WORDS, MISC + 8);
    const int lo = args.ph_lo, hi = args.ph_hi;
#define IN(k) (lo <= (k) && (k) < hi)
#define BOTH(k) (IN(k) && IN((k) + 1))
#define GRID_BAR() xcd_barrier(bar)
    const int gw = vcu * NWAVES + wave, NGW = G * NWAVES;

    if (IN(0)) {
        LAS float* scr = (LAS float*)(lds + RING_OFF + wave * 16384);
        bf16* XB = (bf16*)(ws + WS_XB); unsigned* XF8 = (unsigned*)(ws + WS_XF8); float* rstd1 = (float*)(ws + WS_RSTD1);
        {
            f32x4 va[8], vb[8];
            int m = gw;
            if (m < T && !(args.pad & 8)) { x_ldrow(p.x, m, lane, va);
                for (;;) { const bool hb = m + NGW < T; if (hb) x_ldrow(p.x, m + NGW, lane, vb); x_strow(XB, XF8, rstd1, m, lane, va); if (!hb) break; m += NGW;
                           const bool ha = m + NGW < T; if (ha) x_ldrow(p.x, m + NGW, lane, va); x_strow(XB, XF8, rstd1, m, lane, vb); if (!ha) break; m += NGW; } }
        }
        t_run<0>(p, gw, NGW, lane, scr); t_run<8>(p, gw, NGW, lane, scr);
        t_run<1>(p, gw, NGW, lane, scr); t_run<2>(p, gw, NGW, lane, scr); t_run<3>(p, gw, NGW, lane, scr); t_run<4>(p, gw, NGW, lane, scr);
        if (!(args.pad & 4)) { t_run<7>(p, gw, NGW, lane, scr); t_run<5>(p, gw, NGW, lane, scr, 0, 8192); t_run<6>(p, gw, NGW, lane, scr, 0, 2048); }
        {
            bf16* WRH = (bf16*)(ws + WS_WRH); bf16* WRL = (bf16*)(ws + WS_WRL); bf16* WGH = (bf16*)(ws + WS_WGH); bf16* WGL = (bf16*)(ws + WS_WGL);
            for (int e = gw * 64 + lane; e < D * 32; e += NGW * 64) { const int kb = e >> 8, col = (e >> 3) & 31, k = kb * 8 + (e & 7);
                const float nw = p.norm_ffn_w[k]; const float w = nw * p.w_re[k * 32 + col]; const bf16 wh = f2bf(w); WRH[e] = wh; WRL[e] = f2bf(w - bf2f(wh));
                const float g = nw * p.w_rg[k * 4 + (col & 3)] * ((col < 4) ? 1.f : 0.f); const bf16 gh = f2bf(g); WGH[e] = gh; WGL[e] = f2bf(g - bf2f(gh)); }
        }
        __syncthreads();
        for (int it = vcu; it < S5G * 8; it += G) p0_s5_kt(p, lds + RING_OFF, it >> 3, it & 7, tid);
        if (BOTH(0)) GRID_BAR();
    }
    if (IN(1)) {
        EpiInproj E{(const float*)(ws + WS_RSTD1), p.b_gate, (bf16*)(ws + WS_U5X), (bf16*)(ws + WS_XL), (bf16*)(ws + WS_GY), (bf16*)(ws + WS_GATES)};
        {   pg8::PlainOrder S; S.init(T, 3584, D, D, D, ws + WS_XB, ws + WS_WINT, G, bx);
            pg8::gemm_phase<EpiInproj, pg8::PlainOrder, true>(lds + RING_OFF, S, E, D, D); }
        {
            constexpr int NB = (T / 256) * (3584 / 256), NF = (T / 256) * (4096 / 256);
            const int r = NB % G, nl = G - r;
            Fp8Order S; S.po.init(T, 4096, D / 2, D / 2, D / 2, ws + WS_XF8, ws + WS_WG8, G, bx);
            if (r == 0) { S.w0 = bx; S.wstep = G; S.wn = 1 << 20; }
            else { int a = (NF - 2 * nl) / G; if (a < 0) a = 0; const int NL = nl * (a + 2);
                if (bx >= r) { S.w0 = bx - r; S.wstep = nl; S.wn = a + 2; } else { S.w0 = NL + bx; S.wstep = r; S.wn = 1 << 20; } }
            pg8::gemm_phase<EpiInproj, Fp8Order, true, true>(lds + RING_OFF, S, E, D / 2, D / 2); }
        for (int it = bx; it < S5G * 8; it += G) p0_s5_build(p, lds + RING_OFF, it >> 3, it & 7, tid);
        if (BOTH(1)) GRID_BAR();
    }
    if (IN(2)) {
        const int lane = lane_now();
        if (bx < S5G) { if (!(args.pad & 512)) {
            const int g = bx;
            {   S5EOrder S{1, 2 * g, 2 * g + 2, (const char*)(ws + WS_U5X), (const char*)(ws + WS_BTE)}; EpiS5E E{(float*)(ws + WS_SEND)};
                pg8::gemm_phase<EpiS5E, S5EOrder, true>(lds + RING_OFF, S, E, S5KT, S5KU); }
            asm volatile("s_waitcnt vmcnt(0)" ::: "memory"); __syncthreads();
            if (wave == 0) { __builtin_amdgcn_fence(__ATOMIC_ACQUIRE, "agent"); scan_s5(p, g, lane); asm volatile("s_waitcnt vmcnt(0)" ::: "memory"); __builtin_amdgcn_fence(__ATOMIC_ACQUIRE, "agent"); }
            __syncthreads();
            {   S5COrder S{1, 4 * g, 4 * g + 4, (const char*)(ws + WS_U5X), (const char*)(ws + WS_BTY)}; EpiS5C E{(const bf16*)(ws + WS_U5X), p.s5_d, (bf16*)(ws + WS_Y5)};
                pg8::gemm_phase<EpiS5C, S5COrder, true>(lds + RING_OFF, S, E, S5KT, S5KT); }
        } } else if (!(args.pad & 1024)) {
            lru_pass<0, true>(p, lds + RING_OFF, G - S5G, bx - S5G, tid, lane, wave, 0, 0);
            lru_mid(p, lds, ctl, args.li, G - S5G, bx - S5G, tid);
            lru_pass<1, true>(p, lds + RING_OFF, G - S5G, bx - S5G, tid, lane, wave, 0, 0);
        }
        if (IN(2) && IN(5)) GRID_BAR();
    }
    if (IN(5)) {
        const int lane = lane_now();
        pg8::PlainOrder S; S.init(T, S5W, S5W, S5W, S5W, ws + WS_Y5, ws + WS_WGLUT, G, bx);
        EpiGlu E{(const bf16*)(ws + WS_Y5), p.s5_b_glu, (bf16*)(ws + WS_OUTC)};
        pg8::gemm_phase<EpiGlu, pg8::PlainOrder, true>(lds + RING_OFF, S, E, S5W, S5W);
        {   const int nun = (T / 256) * (S5W / 256);
            if (bx >= nun && G > nun) { LAS float* scr = (LAS float*)(lds + RING_OFF + wave * 16384); t_run<6>(p, (bx - nun) * NWAVES + wave, (G - nun) * NWAVES, lane, scr, 2048, 8192); }
            else if (G <= nun) { LAS float* scr = (LAS float*)(lds + RING_OFF + wave * 16384); t_run<6>(p, gw, NGW, lane, scr, 2048, 8192); } }
        if (BOTH(5)) GRID_BAR();
    }
    if (IN(6)) {
        ProjOrder S; S.po.init(T, D, D / 2, D / 2, D / 2, ws + WS_OUTC, ws + WS_WPT, G, bx);
        EpiProj E{(const bf16*)(ws + WS_GATES), (bf16*)(ws + WS_MERGED)};
        pg8::gemm_phase<EpiProj, ProjOrder, true, true>(lds + RING_OFF, S, E, D / 2, D / 2);
        if (BOTH(6)) GRID_BAR();
    }
    if (IN(7)) {
        pg8::PlainOrder S; S.init(T, D, D / 2, D / 2, D / 2, ws + WS_MERGED, ws + WS_WOUTT, G, bx);
        EpiWout E{(bf16*)(ws + WS_DELTA), (const bf16*)(ws + WS_XB)};
        pg8::gemm_phase<EpiWout, pg8::PlainOrder, true, true>(lds + RING_OFF, S, E, D / 2, D / 2);
        if (BOTH(7)) GRID_BAR();
    }
    if (IN(8)) {
        const int lane = lane_now();
        router_phase(p, lds + RING_OFF, G, bx, tid, lane, wave, (args.pad & 1) != 0);
        if (BOTH(8)) GRID_BAR();
    }
    LAS unsigned* ecnt = (LAS unsigned*)(lds + ECNT_OFF);
    if (IN(9)) { if (tid < NE) ecnt[tid] = __hip_atomic_load(ctl + CW_ECNT + tid, __ATOMIC_RELAXED, __HIP_MEMORY_SCOPE_AGENT); __syncthreads(); }
    if (IN(9)) {
        int U9 = 0;
        for (int q = 0; q < NE; ++q) U9 += (((int)ecnt[q] + 255) >> 8) * 2;
        U9 = __builtin_amdgcn_readfirstlane(U9);
        for (int rep = (args.pad & 128) ? 0 : 1; rep < 2; ++rep) {
            MoeOrder1 S{G, vcu, ecnt, (const char*)(ws + WS_X1B), (const char*)(ws + WS_WGUT), (const int*)(ws + WS_LISTI), ctl, rep == 1};
            EpiMoe1 E{(const float*)(ws + WS_LISTR), (const float*)(ws + WS_LISTW), (bf16*)(ws + WS_ACT)};
            pg8::gemm_phase<EpiMoe1, MoeOrder1, true, true>(lds + RING_OFF, S, E, D / 2, D / 2); }
        const int U10 = U9 * 4;
        const char* ACTp = (const char*)(ws + WS_ACT); const char* WDp = (const char*)(ws + WS_WDT);
        EpiMoe2 E2{(const int*)(ws + WS_LISTI), (bf16*)(ws + WS_YS8)};
        for (int rep2 = (args.pad & 64) ? 0 : 1; rep2 < 2; ++rep2)
        if (U9 > G && U9 <= 2 * G) {
            const int R2 = U9 - G, GL = G - R2, N0 = 4 * G, N1 = U10 - N0, nh = (3 * R2 < N1) ? 3 * R2 : N1;
            if (vcu >= R2) { moe_wait_round(ctl, 0, G * 8);
                MoeOrder2 S{ecnt, ACTp, WDp, vcu - R2, GL, N0, 1 << 20}; pg8::gemm_phase<EpiMoe2, MoeOrder2, true>(lds + RING_OFF, S, E2, EFF, EFF); }
            moe_wait_round(ctl, 1, R2 * 8);
            if (vcu < R2) { MoeOrder2 S{ecnt, ACTp, WDp, N0 + vcu, R2, N0 + nh, 3}; pg8::gemm_phase<EpiMoe2, MoeOrder2, true>(lds + RING_OFF, S, E2, EFF, EFF); }
            else { MoeOrder2 S{ecnt, ACTp, WDp, N0 + nh + (G - 1 - vcu), GL, U10, 1 << 20}; pg8::gemm_phase<EpiMoe2, MoeOrder2, true>(lds + RING_OFF, S, E2, EFF, EFF); }
        } else
        for (int r = 0; r * G < U9; ++r) {
            int want = U9 - r * G; want = (want > G ? G : want) * 8;
            moe_wait_round(ctl, r, want);
            MoeOrder2 S{ecnt, ACTp, WDp, 4 * r * G + vcu, G, U10, 4};
            pg8::gemm_phase<EpiMoe2, MoeOrder2, true>(lds + RING_OFF, S, E2, EFF, EFF); }
        GRID_BAR();
    }
    if (IN(11)) {
        const int lane = lane_now();
        const unsigned char* YS = (const unsigned char*)(ws + WS_YS8); const bf16* DL = (const bf16*)(ws + WS_DELTA);
#define FIN_LOAD(m_, A, B, C) do { const GAS unsigned* y0_ = (const GAS unsigned*)(YS + (size_t)(2 * (m_)) * D) + lane; \
            const GAS unsigned* y1_ = (const GAS unsigned*)(YS + (size_t)(2 * (m_) + 1) * D) + lane; const GAS u32x2* dd_ = (const GAS u32x2*)(DL + (size_t)(m_) * D) + lane; \
            _Pragma("unroll") for (int j = 0; j < 8; ++j) { A[j] = y0_[64 * j]; B[j] = y1_[64 * j]; C[j] = dd_[64 * j]; } } while (0)
#define FIN_STORE(m_, A, B, C) do { float ss_ = 0.f; f32x4 X[8]; \
            _Pragma("unroll") for (int j = 0; j < 8; ++j) { const f32x2 a01 = __builtin_amdgcn_cvt_pk_f32_fp8(A[j], false), a23 = __builtin_amdgcn_cvt_pk_f32_fp8(A[j], true), b01 = __builtin_amdgcn_cvt_pk_f32_fp8(B[j], false), b23 = __builtin_amdgcn_cvt_pk_f32_fp8(B[j], true); \
                X[j].x = (a01.x + b01.x) * (1.f / 64.f) + __uint_as_float(C[j].x << 16); X[j].y = (a01.y + b01.y) * (1.f / 64.f) + __uint_as_float(C[j].x & 0xffff0000u); \
                X[j].z = (a23.x + b23.x) * (1.f / 64.f) + __uint_as_float(C[j].y << 16); X[j].w = (a23.y + b23.y) * (1.f / 64.f) + __uint_as_float(C[j].y & 0xffff0000u); \
                ss_ += (X[j].x * X[j].x + X[j].y * X[j].y) + (X[j].z * X[j].z + X[j].w * X[j].w); } \
            const float rs_ = rsqrtf(wave_sum(ss_) * (1.f / D) + EPS); GAS f32x4* xo_ = (GAS f32x4*)(p.out + (size_t)(m_) * D) + lane; \
            _Pragma("unroll") for (int j = 0; j < 8; ++j) { const f32x4 nw = *((const f32x4*)p.norm_final_w + lane + 64 * j); xo_[64 * j] = X[j] * rs_ * nw; } } while (0)
        {   unsigned ya0[8], ya1[8], yb0[8], yb1[8]; u32x2 da[8], db[8];
            int m = gw;
            if (m < T) { FIN_LOAD(m, ya0, ya1, da);
                for (;;) { const bool hb = m + NGW < T; if (hb) FIN_LOAD(m + NGW, yb0, yb1, db); FIN_STORE(m, ya0, ya1, da); if (!hb) break; m += NGW;
                           const bool ha = m + NGW < T; if (ha) FIN_LOAD(m + NGW, ya0, ya1, da); FIN_STORE(m, yb0, yb1, db); if (!ha) break; m += NGW; } } }
#undef FIN_LOAD
#undef FIN_STORE
    }
    if (args.pad & 256) { for (int q = 0; q < 8; ++q) GRID_BAR(); }
#undef IN
#undef BOTH
#undef GRID_BAR
}

extern "C" void kernel_launch(void* const* d_in, const int* in_sizes, int n_in, void* d_out, int out_size, void* d_ws, size_t ws_size, hipStream_t stream) {
    static int grid = 0;
    if (grid == 0) {
        if (n_in != 33 || ws_size < WS_END) { fprintf(stderr, "kernel_launch: bad n_in %d or ws_size %zu < %zu\n", n_in, ws_size, (size_t)WS_END); grid = -1; return; }
        int dev = 0, cus = 0, per_cu = 0;
        if (hipGetDevice(&dev) != hipSuccess || hipDeviceGetAttribute(&cus, hipDeviceAttributeMultiprocessorCount, dev) != hipSuccess) { grid = -1; return; }
        if (hipFuncSetAttribute((const void*)mk_fwd, hipFuncAttributeMaxDynamicSharedMemorySize, LDS_BYTES) != hipSuccess) { fprintf(stderr, "kernel_launch: hipFuncSetAttribute failed\n"); grid = -1; return; }
        if (hipOccupancyMaxActiveBlocksPerMultiprocessor(&per_cu, (const void*)mk_fwd, NWAVES * 64, LDS_BYTES) != hipSuccess || per_cu < 1) { fprintf(stderr, "kernel_launch: occupancy query says %d blocks per CU\n", per_cu); grid = -1; return; }
        (void)hipGetLastError();
        if (cus < 248) { fprintf(stderr, "kernel_launch: %d CUs: the fused mixer phase needs at least 248 workgroups\n", cus); grid = -1; return; }
        grid = cus;
    }
    if (grid < 0) return;
    Args a{};
    const float** f = (const float**)&a.p;
    for (int i = 0; i < 33; ++i) f[i] = (const float*)d_in[i];
    a.p.out = (float*)d_out; a.p.ws = (unsigned char*)d_ws;
    const P& p = a.p; unsigned char* ws = p.ws;
    (void)hipMemsetAsync(ws + WS_CTL, 0, CTL_ZERO_BYTES, stream);
#if defined(PROBE_LO)
    a.ph_lo = 0; a.ph_hi = PROBE_HI; a.li = 0;
#if defined(PROBE_DRY)
    a.pad = PROBE_DRY;
#endif
    hipLaunchKernelGGL(mk_fwd, dim3(grid), dim3(NWAVES * 64), LDS_BYTES, stream, a);
    a.ph_lo = PROBE_LO; a.ph_hi = 12; a.li = 1; a.pad = 0;
    hipLaunchKernelGGL(mk_fwd, dim3(grid), dim3(NWAVES * 64), LDS_BYTES, stream, a);
#else
    a.ph_lo = 0; a.ph_hi = 12; a.li = 0;
#if defined(PROBE_SINGLE)
    a.pad = PROBE_SINGLE;
#endif
    hipLaunchKernelGGL(mk_fwd, dim3(grid), dim3(NWAVES * 64), LDS_BYTES, stream, a);
#endif
}
```

```cpp
#include <hip/hip_runtime.h>
#include <stdint.h>
#include <stdio.h>

constexpr int T = 16384, D = 2048;
constexpr int S5W = 512, S5G = 32, S5GS = 16, S5P = 64;
constexpr int LW = 1536, LH = 12, LHD = 128;
constexpr int INC = 7680;
constexpr int NE = 32, EFF = 256;
constexpr float EPS = 1e-6f;

typedef unsigned short bf16;
#define LAS __attribute__((address_space(3)))
#define GAS __attribute__((address_space(1)))
typedef short bf16x8 __attribute__((ext_vector_type(8)));
typedef float f32x4 __attribute__((ext_vector_type(4)));
typedef float f32x2 __attribute__((ext_vector_type(2)));
typedef float f32x16 __attribute__((ext_vector_type(16)));
typedef unsigned u32x4 __attribute__((ext_vector_type(4)));
typedef unsigned u32x2 __attribute__((ext_vector_type(2)));
typedef int i32x8 __attribute__((ext_vector_type(8)));
typedef int i32x4 __attribute__((ext_vector_type(4)));

__device__ __forceinline__ float bf2f(bf16 v) { return __uint_as_float(((unsigned)v) << 16); }
__device__ __forceinline__ bf16 f2bf(float f) { unsigned u = __float_as_uint(f); return (bf16)((u + 0x7fffu + ((u >> 16) & 1u)) >> 16); }
__device__ __forceinline__ unsigned pk2(float lo, float hi) { return (unsigned)f2bf(lo) | ((unsigned)f2bf(hi) << 16); }
__device__ __forceinline__ unsigned cvt_pk_bf16(float lo, float hi) { unsigned r; asm volatile("v_cvt_pk_bf16_f32 %0, %1, %2" : "=v"(r) : "v"(lo), "v"(hi)); return r; }
__device__ __forceinline__ float sigmoidf_(float v) { return 1.f / (1.f + __expf(-v)); }
__device__ __forceinline__ float gelu_tanh(float v) { const float u = 0.7978845608028654f * (v + 0.044715f * v * v * v); return 0.5f * v * (1.f + tanhf(u)); }
#define F8PK(a, b, old, hi) __builtin_amdgcn_cvt_pk_fp8_f32(__builtin_amdgcn_fmed3f((a), -448.f, 448.f), __builtin_amdgcn_fmed3f((b), -448.f, 448.f), (old), (hi))
__device__ __forceinline__ float fsig(float v) { return __builtin_amdgcn_rcpf(1.f + __builtin_amdgcn_exp2f(-1.4426950408889634f * v)); }
__device__ __forceinline__ float fgelu(float v) { const float u2 = 1.5957691216057308f * (v + 0.044715f * v * v * v); return v * fsig(u2); }

constexpr int LC = 32, NCH = T / LC;
constexpr int S5KU = LC * 16, S5KT = S5KU + 128;
constexpr int LTT = 64, LNT = T / LTT;
constexpr size_t MiB = 1u << 20;
constexpr size_t WS_CTL   = 0, CTL_ZERO_BYTES = 1 * MiB;
constexpr size_t WS_RSTD1 = 1 * MiB;
constexpr size_t WS_LAML  = 1 * MiB + 128 * 1024;
constexpr size_t WS_WRH   = 1 * MiB + 256 * 1024;
constexpr size_t WS_WRL   = 1 * MiB + 384 * 1024;
constexpr size_t WS_WGH   = 1 * MiB + 512 * 1024;
constexpr size_t WS_WGL   = 1 * MiB + 640 * 1024;
constexpr size_t WS_WG    = 1 * MiB + 192 * 1024;
constexpr size_t WS_WR    = 1 * MiB + 768 * 1024;
constexpr size_t WS_WGLUT = 2 * MiB;
constexpr size_t WS_WLT   = 3 * MiB;
constexpr size_t WS_KTG   = 7 * MiB;
constexpr size_t WS_WG8   = 9 * MiB;
constexpr size_t WS_KTG_OLD = 8 * MiB + 512 * 1024;
constexpr size_t WS_AG    = 4 * MiB;
constexpr size_t WS_HIN   = 7 * MiB;
constexpr size_t WS_SEND  = 9 * MiB;
constexpr size_t WS_LISTI = 9 * MiB;
constexpr size_t WS_LISTR = 11 * MiB;
constexpr size_t WS_LISTW = 13 * MiB;
constexpr size_t WS_BTE   = 17 * MiB;
constexpr size_t WS_BTY   = 21 * MiB;
constexpr size_t WS_WPT   = 41 * MiB;
constexpr size_t WS_WOUTT = 49 * MiB;
constexpr size_t WS_WGUT  = 57 * MiB;
constexpr size_t WS_WDT   = 121 * MiB;
constexpr size_t WS_U5X   = 153 * MiB;
constexpr size_t WS_XL    = 173 * MiB;
constexpr size_t WS_GY    = 221 * MiB;
constexpr size_t WS_GATES = 269 * MiB;
constexpr size_t WS_XB    = 397 * MiB;
constexpr size_t WS_WINT  = 461 * MiB;
constexpr size_t WS_XF8   = 475 * MiB;
constexpr size_t WS_Y5    = 461 * MiB;
constexpr size_t WS_OUTC  = 477 * MiB;
constexpr size_t WS_X1B   = 173 * MiB;
constexpr size_t WS_OUTL  = 57 * MiB;
constexpr size_t WS_MERGED= 153 * MiB;
constexpr size_t WS_ACT   = 461 * MiB;
constexpr size_t WS_YS8   = 333 * MiB;
constexpr size_t WS_DELTA = 269 * MiB;
constexpr size_t WS_END   = 509 * MiB;

struct P {
    const float *x, *norm_mix_w, *w_in, *b_gate, *s5_lam_re, *s5_lam_im, *s5_log_step, *s5_b_re, *s5_b_im, *s5_c_re, *s5_c_im, *s5_d, *s5_w_glu, *s5_b_glu;
    const float *lru_conv_w, *lru_conv_b, *lru_w_a, *lru_b_a, *lru_w_x, *lru_b_x, *lru_lambda, *w_proj_s5, *w_proj_lru, *w_out, *norm_ffn_w;
    const float *w_rg, *b_rg, *w_re, *b_re, *w_e_gate, *w_e_up, *w_e_down, *norm_final_w;
    float* out; unsigned char* ws;
};

namespace pg8 {
constexpr int BM = 256, BK = 64, HALF = 128, HTB = HALF * BK * 2  , STAGE_BYTES = 8 * HTB, NXCD = 8, WGM = 8;
__host__ __device__ __forceinline__ int lds_byte(int r, int c) { const int st = (r >> 4) * 2 + (c >> 5), rr = r & 15, cc = c & 31, ob = rr * 64 + cc * 2; return st * 1024 + (ob ^ (((ob >> 9) & 1) << 5)); }
__host__ __device__ __forceinline__ void stage_rc(int b, int& R, int& C) { const int st = b / 1024, sb = b % 1024, swz = sb ^ (((sb >> 9) & 1) << 5); R = (st >> 1) * 16 + swz / 64; C = (st & 1) * 32 + (swz % 64) / 2; }
__host__ __device__ __forceinline__ int perm32(int rho) { const int n = rho >> 4, i = rho & 15; return 8 * (i >> 2) + 4 * n + (i & 3); }

struct Unit { int pm, pn; const char* A; const char* B; int nt; int aux, aux2, aux3, unit_i; };

struct PlainOrder {
    static constexpr bool GATHER = false;
    int nM, nN, nwg, G, c, nt; const char* A; const char* B; size_t astep, bstep;
    __device__ void init(int M, int N, int K, int lda, int ldb, const void* A_, const void* B_, int G_, int c_) {
        nM = M / BM; nN = N / BM; nwg = nM * nN; G = G_; c = c_; nt = K / BK; A = (const char*)A_; B = (const char*)B_; astep = (size_t)BM * lda * 2; bstep = (size_t)BM * ldb * 2; }
    __device__ bool next(int i, Unit& u) const { return next_L((long)i * G + c, u); }
    __device__ bool next_L(long L, Unit& u) const {
        if (L >= nwg) return false;
        int wgid = (int)L; { const int q = nwg / NXCD, r = nwg % NXCD, xcd = wgid % NXCD, off = wgid / NXCD; wgid = (xcd < r ? xcd * (q + 1) : r * (q + 1) + (xcd - r) * q) + off; }
        const int nig = WGM * nN, gid = wgid / nig, fm = gid * WGM, gsz = (nM - fm) < WGM ? (nM - fm) : WGM;
        u.pm = fm + ((wgid % nig) % gsz); u.pn = (wgid % nig) / gsz; u.A = A + (size_t)u.pm * astep; u.B = B + (size_t)u.pn * bstep; u.nt = nt; u.aux = 0; return true;
    }
    __device__ __forceinline__ void a_offsets(const Unit&, const int (&)[2], const int (&)[2], unsigned (&)[2][2]) const {}
    __device__ __forceinline__ void a_ready(const Unit&) const {}
    __device__ __forceinline__ void done(const Unit&) const {}
};

template <class Epi, class Sched, bool ALIGN_EPI, bool FP8 = false>
__device__ __forceinline__ void gemm_phase(LAS unsigned char* lds, const Sched& S, const Epi& E, int lda, int ldb) {
    const int tid = threadIdx.x, wid = __builtin_amdgcn_readfirstlane(tid >> 6), lane = tid & 63, wr = wid >> 2, wc = wid & 3, fr = lane & 15, fq = lane >> 4;
    unsigned voffAc[2][2], voffAn[2][2], voffB[2]; int Ra[2], Ca[2];
#pragma unroll
    for (int i = 0; i < 2; ++i) { int R, C; stage_rc(tid * 16 + i * 8192, R, C); const int Rb = Epi::PERM ? ((R & ~31) + perm32(R & 31)) : R;
        Ra[i] = R; Ca[i] = C * 2;
        voffAc[0][i] = (unsigned)(R * lda + C) * 2u; voffAc[1][i] = (unsigned)((R + HALF) * lda + C) * 2u; voffB[i] = (unsigned)(Rb * ldb + C) * 2u; }
    const size_t kstep = (size_t)(BK * 2);
    const size_t hstepB = (size_t)HALF * ldb * 2;
    const unsigned ldsw = (unsigned)wid * 1024u;
    const int aoff = lds_byte(wr * 64 + fr, fq * 8), boff = lds_byte(wc * 32 + fr, fq * 8);
#define PG8_SA(b, h) (((b) * 2 + (h)) * HTB)
#define PG8_SB(b, h) ((4 + (b) * 2 + (h)) * HTB)
#define PG8_STAGE2(bufoff, gbase, o0, o1) do { \
        __builtin_amdgcn_global_load_lds((const unsigned*)((const char*)(gbase) + (o0)), (LAS unsigned*)(lds + (bufoff) + ldsw), 16, 0, 0); \
        __builtin_amdgcn_global_load_lds((const unsigned*)((const char*)(gbase) + (o1)), (LAS unsigned*)(lds + (bufoff) + ldsw + 8192), 16, 0, 0); } while (0)
#define PG8_STAGE_B(bufoff, gbase) PG8_STAGE2(bufoff, gbase, voffB[0], voffB[1])
#define PG8_STAGE_AC(bufoff, gbase, h) PG8_STAGE2(bufoff, gbase, voffAc[h][0], voffAc[h][1])
#define PG8_STAGE_AX(bufoff, gbase, h) PG8_STAGE2(bufoff, gbase, (Sched::GATHER && last) ? voffAn[h][0] : voffAc[h][0], (Sched::GATHER && last) ? voffAn[h][1] : voffAc[h][1])
#define PG8_LD16(off) (*(const LAS i32x4*)(lds + (off)))
#define PG8_LDA(dst, b, h) do { if constexpr (FP8) { _Pragma("unroll") for (int m = 0; m < 4; ++m) dst##8[m] = __builtin_shufflevector(PG8_LD16(PG8_SA(b, h) + aoff + m * 2048), PG8_LD16(PG8_SA(b, h) + aoff + m * 2048 + 1024), 0, 1, 2, 3, 4, 5, 6, 7); } \
        else { _Pragma("unroll") for (int m = 0; m < 4; ++m) _Pragma("unroll") for (int k = 0; k < 2; ++k) dst[m][k] = *(const LAS bf16x8*)(lds + PG8_SA(b, h) + aoff + m * 2048 + k * 1024); } } while (0)
#define PG8_LDB(dst, b, h) do { if constexpr (FP8) { _Pragma("unroll") for (int n = 0; n < 2; ++n) dst##8[n] = __builtin_shufflevector(PG8_LD16(PG8_SB(b, h) + boff + n * 2048), PG8_LD16(PG8_SB(b, h) + boff + n * 2048 + 1024), 0, 1, 2, 3, 4, 5, 6, 7); } \
        else { _Pragma("unroll") for (int n = 0; n < 2; ++n) _Pragma("unroll") for (int k = 0; k < 2; ++k) dst[n][k] = *(const LAS bf16x8*)(lds + PG8_SB(b, h) + boff + n * 2048 + k * 1024); } } while (0)
#define PG8_MMA(ai, bj, At, Bt) do { __builtin_amdgcn_s_setprio(1); \
        if constexpr (FP8) { _Pragma("unroll") for (int m = 0; m < 4; ++m) _Pragma("unroll") for (int n = 0; n < 2; ++n) \
            asm volatile("v_mfma_f32_16x16x128_f8f6f4 %0, %1, %2, %0" : "+v"(acc[ai][bj][m][n]) : "v"(Bt##8[n]), "v"(At##8[m])); } \
        else { _Pragma("unroll") for (int m = 0; m < 4; ++m) _Pragma("unroll") for (int n = 0; n < 2; ++n) _Pragma("unroll") for (int k = 0; k < 2; ++k) \
            acc[ai][bj][m][n] = __builtin_amdgcn_mfma_f32_16x16x32_bf16(Bt[n][k], At[m][k], acc[ai][bj][m][n], 0, 0, 0); } \
        __builtin_amdgcn_s_setprio(0); } while (0)
#define PG8_WAIT_V(n) asm volatile("s_waitcnt vmcnt(" #n ")" ::: "memory")
#define PG8_WAIT_L(n) asm volatile("s_waitcnt lgkmcnt(" #n ")" ::: "memory")
#define PG8_BAR __builtin_amdgcn_s_barrier()
#define PG8_SCHED __builtin_amdgcn_sched_barrier(0)
    Unit cur, nxt; int ui = 0;
    if (!S.next(0, cur)) return;
    if constexpr (Sched::GATHER) S.a_offsets(cur, Ra, Ca, voffAc);
    f32x4 acc[2][2][4][2];
#pragma unroll
    for (int a = 0; a < 2; ++a)
#pragma unroll
        for (int b = 0; b < 2; ++b)
#pragma unroll
            for (int m = 0; m < 4; ++m)
#pragma unroll
                for (int n = 0; n < 2; ++n) acc[a][b][m][n] = (f32x4){0.f, 0.f, 0.f, 0.f};
    if constexpr (FP8) {
#pragma unroll
        for (int a = 0; a < 2; ++a)
#pragma unroll
            for (int b = 0; b < 2; ++b)
#pragma unroll
                for (int m = 0; m < 4; ++m)
#pragma unroll
                    for (int n = 0; n < 2; ++n) asm volatile("" : "+v"(acc[a][b][m][n]));
        asm volatile("s_nop 4" ::: "memory"); }
    bf16x8 At[4][2], B0[2][2], B1[2][2];
    i32x8 At8[4], B08[2], B18[2];
    int f8scale = 0x7f7f7f7f;
    if constexpr (FP8) asm volatile("v_mov_b32 %0, 0x7f7f7f7f\n\ts_nop 4" : "=v"(f8scale));
    const char* cA = cur.A; const char* cB = cur.B;
    S.a_ready(cur);
    PG8_STAGE_B(PG8_SB(0, 0), cB); PG8_STAGE_B(PG8_SB(0, 1), cB + hstepB); PG8_STAGE_AC(PG8_SA(0, 0), cA, 0); PG8_STAGE_AC(PG8_SA(0, 1), cA, 1);
    if (wr == 1) PG8_BAR;
    PG8_WAIT_V(2); PG8_BAR;
    PG8_STAGE_B(PG8_SB(1, 0), cB + kstep); PG8_STAGE_AC(PG8_SA(1, 0), cA + kstep, 0); PG8_STAGE_B(PG8_SB(1, 1), cB + hstepB + kstep);
    PG8_WAIT_V(6); PG8_BAR;
    for (;;) {
        const bool has_next = S.next(ui + 1, nxt);
        const char* nA = has_next ? nxt.A : cA; const char* nB = has_next ? nxt.B : cB;
        if constexpr (Sched::GATHER) {
            if (has_next) S.a_offsets(nxt, Ra, Ca, voffAn);
            else { voffAn[0][0] = voffAc[0][0]; voffAn[0][1] = voffAc[0][1]; voffAn[1][0] = voffAc[1][0]; voffAn[1][1] = voffAc[1][1]; }
        }
        const int nt = cur.nt;
        for (int t = 0; t < nt; t += 2) {
            const bool last = (t == nt - 2);
            if (last && has_next) S.a_ready(nxt);
            const char* a1 = cA + (size_t)(t + 1) * kstep;
            const char* a2 = last ? nA : cA + (size_t)(t + 2) * kstep; const char* b2 = last ? nB : cB + (size_t)(t + 2) * kstep;
            const char* a3 = a2 + kstep; const char* b3 = b2 + kstep;
            PG8_LDB(B0, 0, 0); PG8_LDB(B1, 0, 1); PG8_SCHED; PG8_LDA(At, 0, 0); PG8_STAGE_AC(PG8_SA(1, 1), a1, 1);
            PG8_WAIT_V(8); PG8_WAIT_L(0); PG8_BAR; PG8_MMA(0, 0, At, B0); PG8_MMA(0, 1, At, B1); PG8_BAR; PG8_SCHED;
            PG8_LDA(At, 0, 1); PG8_STAGE_B(PG8_SB(0, 0), b2); PG8_STAGE_B(PG8_SB(0, 1), b2 + hstepB); PG8_STAGE_AX(PG8_SA(0, 0), a2, 0);
            PG8_WAIT_V(8); PG8_WAIT_L(0); PG8_BAR; PG8_MMA(1, 0, At, B0); PG8_MMA(1, 1, At, B1); PG8_BAR; PG8_SCHED;
            PG8_LDB(B0, 1, 0); PG8_LDB(B1, 1, 1); PG8_SCHED; PG8_LDA(At, 1, 0); PG8_STAGE_AX(PG8_SA(0, 1), a2, 1);
            PG8_WAIT_V(8); PG8_WAIT_L(0); PG8_BAR; PG8_MMA(0, 0, At, B0); PG8_MMA(0, 1, At, B1); PG8_BAR; PG8_SCHED;
            PG8_LDA(At, 1, 1); PG8_STAGE_B(PG8_SB(1, 0), b3); PG8_STAGE_B(PG8_SB(1, 1), b3 + hstepB); PG8_STAGE_AX(PG8_SA(1, 0), a3, 0);
            PG8_WAIT_V(8); PG8_WAIT_L(0); PG8_BAR; PG8_MMA(1, 0, At, B0); PG8_MMA(1, 1, At, B1); PG8_BAR; PG8_SCHED;
        }
        if constexpr (ALIGN_EPI) { if (wr == 0) PG8_BAR; }
        if constexpr (FP8) { __builtin_amdgcn_sched_barrier(0); asm volatile("s_nop 15\n\ts_nop 7" ::: "memory"); __builtin_amdgcn_sched_barrier(0); }
        E(acc, cur, wr, wc, fr, fq); S.done(cur);
        if (!has_next) break;
        if (!(Epi::KEEP && cur.aux == 0))
#pragma unroll
        for (int a = 0; a < 2; ++a)
#pragma unroll
            for (int b = 0; b < 2; ++b)
#pragma unroll
                for (int m = 0; m < 4; ++m)
#pragma unroll
                    for (int n = 0; n < 2; ++n) acc[a][b][m][n] = (f32x4){0.f, 0.f, 0.f, 0.f};
        if constexpr (FP8) {
#pragma unroll
            for (int a = 0; a < 2; ++a)
#pragma unroll
                for (int b = 0; b < 2; ++b)
#pragma unroll
                    for (int m = 0; m < 4; ++m)
#pragma unroll
                        for (int n = 0; n < 2; ++n) asm volatile("" : "+v"(acc[a][b][m][n]));
            asm volatile("s_nop 4" ::: "memory"); }
        cur = nxt; cA = nA; cB = nB; ++ui;
        if constexpr (Sched::GATHER) { voffAc[0][0] = voffAn[0][0]; voffAc[0][1] = voffAn[0][1]; voffAc[1][0] = voffAn[1][0]; voffAc[1][1] = voffAn[1][1]; }
        if constexpr (ALIGN_EPI) { if (wr == 1) PG8_BAR; }
    }
    PG8_WAIT_V(0);
    if constexpr (!ALIGN_EPI) { if (wr == 0) PG8_BAR; }
    PG8_BAR;
#undef PG8_SA
#undef PG8_SB
#undef PG8_STAGE2
#undef PG8_STAGE_B
#undef PG8_STAGE_AC
#undef PG8_STAGE_AX
#undef PG8_LDA
#undef PG8_LDB
#undef PG8_MMA
#undef PG8_LD16
#undef PG8_WAIT_V
#undef PG8_WAIT_L
#undef PG8_BAR
#undef PG8_SCHED
}
}

#define XB_TMO      128
#define XB_XCNT(j)  (256  + 64 * (j))
#define XB_XSUB(j)  (1280 + 64 * (j))
#define XB_XGEN(j)  (2304 + 64 * (j))
#define XB_TOP      3328
#define XB_TOPGEN   3392
#define XCD_BAR_WORDS 3456
#define XB_SPIN_CAP (1u << 18)
__device__ __forceinline__ unsigned xb_ld(unsigned* p)              { return __hip_atomic_load(p, __ATOMIC_RELAXED, __HIP_MEMORY_SCOPE_AGENT); }
__device__ __forceinline__ unsigned xb_add(unsigned* p, unsigned v) { return __hip_atomic_fetch_add(p, v, __ATOMIC_RELAXED, __HIP_MEMORY_SCOPE_AGENT); }
__device__ __forceinline__ unsigned xb_xcc_id() { return (unsigned)__builtin_amdgcn_s_getreg((3 << 11) | 20) & 0xFu; }
#define XB_SPIN(cond, bar) do { unsigned _sp = 0; while (cond) { __builtin_amdgcn_s_sleep(1); \
    if ((++_sp & 255u) == 0u) { if (xb_ld(&(bar)[XB_TMO])) break; if (_sp > XB_SPIN_CAP) { atomicAdd(&(bar)[XB_TMO], 1u); break; } } } } while (0)
struct XcdBarrier { unsigned* bar; unsigned x; volatile LAS unsigned* st; };
__device__ __forceinline__ XcdBarrier xcd_barrier_post(unsigned* bar, volatile LAS unsigned* st) {
    XcdBarrier b; b.bar = bar; b.x = xb_xcc_id(); b.st = st;
    if (threadIdx.x == 0) (void)xb_add(&bar[XB_XCNT(b.x)], 1u);
    return b;
}
__device__ __forceinline__ void xcd_barrier_complete(unsigned* bar, unsigned x, unsigned& nloc, unsigned& nx) {
    const unsigned G = gridDim.x * gridDim.y * gridDim.z;
    unsigned sum, cnt, mine, sp = 0u;
    for (;;) {
        sum = 0u; cnt = 0u; mine = 0u;
#pragma unroll
        for (unsigned j = 0; j < 16; ++j) { const unsigned c = xb_ld(&bar[XB_XCNT(j)]); sum += c; cnt += (c > 0u) ? 1u : 0u; mine = (j == x) ? c : mine; }
        if (sum == G) break;
        __builtin_amdgcn_s_sleep(1);
        if ((++sp & 255u) == 0u) { if (xb_ld(&bar[XB_TMO])) break; if (sp > XB_SPIN_CAP) { atomicAdd(&bar[XB_TMO], 1u); break; } }
    }
    nloc = mine > 0u ? mine : 1u; nx = cnt > 0u ? cnt : 1u;
}
__device__ __forceinline__ void xcd_barrier(const XcdBarrier& b) {
    asm volatile("s_waitcnt vmcnt(0)" ::: "memory");
    __syncthreads();
    if (threadIdx.x == 0) {
        unsigned* bar = b.bar;
        __builtin_amdgcn_s_waitcnt(0);
        unsigned nloc = b.st[0], nx = b.st[1];
        if (nloc == 0u) { xcd_barrier_complete(bar, b.x, nloc, nx); b.st[0] = nloc; b.st[1] = nx; }
        const unsigned old = xb_add(&bar[XB_XSUB(b.x)], 1u);
        const unsigned gen = old / nloc;
        if (old + 1u == (gen + 1u) * nloc) {
            __builtin_amdgcn_fence(__ATOMIC_RELEASE, "agent");
            asm volatile("s_waitcnt vmcnt(0)" ::: "memory");
            const unsigned og = xb_add(&bar[XB_TOP], 1u);
            const unsigned tg = og / nx;
            if (og + 1u == (tg + 1u) * nx) xb_add(&bar[XB_TOPGEN], 1u);
            else XB_SPIN(xb_ld(&bar[XB_TOPGEN]) == tg, bar);
            __builtin_amdgcn_fence(__ATOMIC_ACQUIRE, "agent");
            xb_add(&bar[XB_XGEN(b.x)], 1u);
            asm volatile("s_waitcnt vmcnt(0)" ::: "memory");
        } else {
            XB_SPIN(xb_ld(&bar[XB_XGEN(b.x)]) == gen, bar);
            __builtin_amdgcn_fence(__ATOMIC_ACQUIRE, "agent");
            asm volatile("s_waitcnt vmcnt(0)" ::: "memory");
        }
    }
    __syncthreads();
}

constexpr int NWAVES = 8;
constexpr int RING_OFF = 0, RING_BYTES = 131072;
constexpr int LDSCTL_OFF = RING_BYTES, MISC_OFF = LDSCTL_OFF + 320;
constexpr int LDS_BYTES = 147456;
constexpr int LRU_PRE_OFF = 132096, LRU_SG4_OFF = 119808;
constexpr int CW_BAR = 4096;

#define LDS_WAIT() asm volatile("s_waitcnt lgkmcnt(0)" ::: "memory")
#define VM_WAIT() asm volatile("s_waitcnt vmcnt(0)" ::: "memory")

struct Args { P p; int ph_lo, ph_hi, li, pad; };

__device__ __forceinline__ int lane_now() { int l; asm volatile("v_mbcnt_lo_u32_b32 %0, -1, 0\n\tv_mbcnt_hi_u32_b32 %0, -1, %0" : "=v"(l)); return l; }
__device__ __forceinline__ float wave_sum(float v) {
#pragma unroll
    for (int o = 1; o < 64; o <<= 1) v += __shfl_xor(v, o);
    return v;
}
__device__ __forceinline__ void x_ldrow(const float* x, int m, int lane, f32x4 (&v)[8]) {
    const GAS f32x4* xr = (const GAS f32x4*)(x + (size_t)m * D) + lane;
#pragma unroll
    for (int j = 0; j < 8; ++j) v[j] = xr[64 * j];
}
__device__ __forceinline__ void x_strow(bf16* XB, unsigned* XF8, float* rstd1, int m, int lane, const f32x4 (&v)[8]) {
    float s = 0.f;
#pragma unroll
    for (int j = 0; j < 8; ++j) s += (v[j].x * v[j].x + v[j].y * v[j].y) + (v[j].z * v[j].z + v[j].w * v[j].w);
    s = wave_sum(s);
    if (lane == 0) rstd1[m] = rsqrtf(s * (1.f / D) + EPS);
    GAS u32x2* o8 = (GAS u32x2*)(XB + (size_t)m * D) + lane;
#pragma unroll
    for (int j = 0; j < 8; ++j) { u32x2 w; w.x = cvt_pk_bf16(v[j].x, v[j].y); w.y = cvt_pk_bf16(v[j].z, v[j].w); o8[64 * j] = w; }
    GAS unsigned* o4 = (GAS unsigned*)(XF8 + (size_t)m * (D / 4)) + lane;
#pragma unroll
    for (int j = 0; j < 8; ++j) { unsigned w = 0; w = F8PK(v[j].x, v[j].y, w, false); w = F8PK(v[j].z, v[j].w, w, true); o4[64 * j] = w; }
}
struct TItem { const float* src; bf16* dst; const float* ks; int ldw, ldk; };
template <bool HAS_KS> __device__ __forceinline__ void t_load(const TItem& t, int lane, f32x4 (&v)[8], float (&kv)[8]) {
    const int r8 = lane >> 3, c8 = lane & 7;
#pragma unroll
    for (int i = 0; i < 8; ++i) { v[i] = *(const GAS f32x4*)(t.src + (size_t)(8 * i + r8) * t.ldw + 4 * c8); if (HAS_KS) kv[i] = t.ks[8 * i + r8]; else kv[i] = 1.f; }
}
template <bool F8 = false> __device__ __forceinline__ void t_store(const TItem& t, int lane, const f32x4 (&v)[8], const float (&kv)[8], LAS float* scr) {
    const int r8 = lane >> 3, c8 = lane & 7;
#pragma unroll
    for (int i = 0; i < 8; ++i) {
#pragma unroll
        for (int e = 0; e < 4; ++e) scr[(4 * c8 + e) * 65 + 8 * i + r8] = v[i][e] * kv[i]; }
    LDS_WAIT(); asm volatile("" ::: "memory");
#pragma unroll
    for (int j = 0; j < 4; ++j) { const int n = r8 + 8 * j; const LAS float* sp = scr + n * 65 + 8 * c8;
        if constexpr (F8) {
            u32x2 o; unsigned w = 0; w = F8PK(sp[0] * 64.f, sp[1] * 64.f, w, false); w = F8PK(sp[2] * 64.f, sp[3] * 64.f, w, true); o.x = w;
            w = 0; w = F8PK(sp[4] * 64.f, sp[5] * 64.f, w, false); w = F8PK(sp[6] * 64.f, sp[7] * 64.f, w, true); o.y = w;
            *(GAS u32x2*)((unsigned char*)t.dst + (size_t)n * t.ldk + 8 * c8) = o; }
        else {
        u32x4 o; o.x = cvt_pk_bf16(sp[0], sp[1]); o.y = cvt_pk_bf16(sp[2], sp[3]); o.z = cvt_pk_bf16(sp[4], sp[5]); o.w = cvt_pk_bf16(sp[6], sp[7]);
        *(GAS u32x4*)(t.dst + (size_t)n * t.ldk + 8 * c8) = o; } }
    LDS_WAIT(); asm volatile("" ::: "memory");
}
template <int KIND> struct TKind;
template <> struct TKind<0> { static constexpr int N = (D / 64) * (3584 / 32); static constexpr bool KS = true; };
template <> struct TKind<8> { static constexpr int N = (D / 64) * (4096 / 32); static constexpr bool KS = true; };
template <> struct TKind<1> { static constexpr int N = (S5W / 64) * (S5W / 32); static constexpr bool KS = false; };
template <> struct TKind<2> { static constexpr int N = LH * 2 * 8; static constexpr bool KS = false; };
template <> struct TKind<3> { static constexpr int N = (D / 64) * (D / 32); static constexpr bool KS = false; };
template <> struct TKind<4> { static constexpr int N = (D / 64) * (D / 32); static constexpr bool KS = false; };
template <> struct TKind<5> { static constexpr int N = NE * 256; static constexpr bool KS = true; };
template <> struct TKind<6> { static constexpr int N = NE * 256; static constexpr bool KS = true; };
template <> struct TKind<7> { static constexpr int N = NE * 256; static constexpr bool KS = false; };
template <int KIND> __device__ __forceinline__ void t_decode(const P& p, int it, TItem& t) {
    unsigned char* ws = p.ws;
    if constexpr (KIND == 8) { const int kb = it / 128, nb = it % 128; t.src = p.w_in + (size_t)(64 * kb) * INC + 3584 + 32 * nb; t.ldw = INC; t.dst = (bf16*)(ws + WS_WG8 + (size_t)(32 * nb) * D + 64 * kb); t.ldk = D; t.ks = p.norm_mix_w + 64 * kb; }
    if constexpr (KIND == 0) { const int kb = it / (3584 / 32), nb = it % (3584 / 32); t.src = p.w_in + (size_t)(64 * kb) * INC + 32 * nb; t.ldw = INC; t.dst = (bf16*)(ws + WS_WINT) + (size_t)(32 * nb) * D + 64 * kb; t.ldk = D; t.ks = p.norm_mix_w + 64 * kb; }
    if constexpr (KIND == 1) { const int kb = it / (S5W / 32), nb = it % (S5W / 32); t.src = p.s5_w_glu + (size_t)(64 * kb) * S5W + 32 * nb; t.ldw = S5W; t.dst = (bf16*)(ws + WS_WGLUT) + (size_t)(32 * nb) * S5W + 64 * kb; t.ldk = S5W; t.ks = nullptr; }
    if constexpr (KIND == 2) { const int hg = it >> 3, sub = it & 7, hh = hg >> 1, gt = hg & 1, kb = sub >> 2, nb = sub & 3;
        const float* wa_ = p.lru_w_a; const float* wx_ = p.lru_w_x; asm volatile("" : "+s"(wa_), "+s"(wx_));
        t.src = (gt ? wx_ : wa_) + (size_t)hh * 128 * 128 + (size_t)(64 * kb) * 128 + 32 * nb; t.ldw = 128;
        t.dst = (bf16*)(ws + WS_WLT) + (size_t)(hh * 256 + gt * 128 + 32 * nb) * 128 + 64 * kb; t.ldk = 128; t.ks = nullptr; }
    if constexpr (KIND == 3) { const int kb = it / (D / 32), nb = it % (D / 32); t.ldw = D; t.ldk = D; t.ks = nullptr;
        const float* w5_ = p.w_proj_s5; const float* wl_ = p.w_proj_lru - (size_t)S5W * D; asm volatile("" : "+s"(w5_), "+s"(wl_));
        t.src = (kb < S5W / 64 ? w5_ : wl_) + (size_t)(64 * kb) * D + 32 * nb; t.dst = (bf16*)(ws + WS_WPT + (size_t)(32 * nb) * D + 64 * kb); }
    if constexpr (KIND == 4) { const int kb = it / (D / 32), nb = it % (D / 32); t.ldw = D; t.ldk = D; t.ks = nullptr;
        t.src = p.w_out + (size_t)(64 * kb) * D + 32 * nb; t.dst = (bf16*)(ws + WS_WOUTT + (size_t)(32 * nb) * D + 64 * kb); }
    if constexpr (KIND == 5 || KIND == 6) { const int e = it >> 8, q = it & 255, kb = q >> 3, nb = q & 7, n0 = 32 * nb;
        t.src = (KIND == 6 ? p.w_e_up : p.w_e_gate) + (size_t)e * D * EFF + (size_t)(64 * kb) * EFF + n0; t.ldw = EFF;
        t.dst = (bf16*)(ws + WS_WGUT + (size_t)(e * 512 + (n0 >> 7) * 256 + (KIND == 6 ? 128 : 0) + (n0 & 127)) * D + 64 * kb); t.ldk = D; t.ks = p.norm_ffn_w + 64 * kb; }
    if constexpr (KIND == 7) { const int e = it >> 8, q = it & 255, kb = q >> 6, nb = q & 63;
        t.src = p.w_e_down + (size_t)e * EFF * D + (size_t)(64 * kb) * D + 32 * nb; t.ldw = D;
        t.dst = (bf16*)(ws + WS_WDT) + (size_t)(e * D + 32 * nb) * EFF + 64 * kb; t.ldk = EFF; t.ks = nullptr; }
}
template <int KIND> __device__ __forceinline__ void t_ld(const P& p, int it, int lane, f32x4 (&v)[8], float (&kv)[8]) { TItem t; t_decode<KIND>(p, it, t); t_load<TKind<KIND>::KS>(t, lane, v, kv); }
template <int KIND> __device__ __forceinline__ void t_st(const P& p, int it, int lane, const f32x4 (&v)[8], const float (&kv)[8], LAS float* scr) { TItem t; t_decode<KIND>(p, it, t); t_store<KIND == 8 || KIND == 5 || KIND == 6 || KIND == 4 || KIND == 3>(t, lane, v, kv, scr); }
template <int KIND> __device__ __forceinline__ void t_run(const P& p, int first, int stride, int lane, LAS float* scr, int lo = 0, int hi = TKind<KIND>::N) {
    const int N = hi;
    f32x4 va[8], vb[8]; float ka[8], kb[8];
    int it = lo + first; if (it >= N) return;
    t_ld<KIND>(p, it, lane, va, ka);
    for (;;) {
        const bool hb = it + stride < N;
        if (hb) t_ld<KIND>(p, it + stride, lane, vb, kb);
        t_st<KIND>(p, it, lane, va, ka, scr);
        if (!hb) break;
        it += stride;
        const bool ha = it + stride < N;
        if (ha) t_ld<KIND>(p, it + stride, lane, va, ka);
        t_st<KIND>(p, it, lane, vb, kb, scr);
        if (!ha) break;
        it += stride;
    }
}

__device__ __forceinline__ void unpack8(const u32x4 w, f32x4& a, f32x4& b) {
    a[0] = __uint_as_float(w.x << 16); a[1] = __uint_as_float(w.x & 0xffff0000u); a[2] = __uint_as_float(w.y << 16); a[3] = __uint_as_float(w.y & 0xffff0000u);
    b[0] = __uint_as_float(w.z << 16); b[1] = __uint_as_float(w.z & 0xffff0000u); b[2] = __uint_as_float(w.w << 16); b[3] = __uint_as_float(w.w & 0xffff0000u); }
__device__ __forceinline__ void unpack8u(const u32x2 w, f32x4& a, f32x4& b) {
    a[0] = (float)(w.x & 0xffu); a[1] = (float)((w.x >> 8) & 0xffu); a[2] = (float)((w.x >> 16) & 0xffu); a[3] = (float)(w.x >> 24);
    b[0] = (float)(w.y & 0xffu); b[1] = (float)((w.y >> 8) & 0xffu); b[2] = (float)((w.y >> 16) & 0xffu); b[3] = (float)(w.y >> 24); }
__device__ __forceinline__ void st16_wt(void* p, u32x4 v) { asm volatile("global_store_dwordx4 %0, %1, off sc1\n\ts_nop 1" :: "v"(p), "v"(v) : "memory"); }
constexpr float GSC = 254.49f;
struct EpiInproj {
    static constexpr bool PERM = true; static constexpr bool KEEP = false;
    const float* rstd; const float* b_gate; bf16* U5; bf16* XL; bf16* GY; bf16* GATES;
    __device__ __forceinline__ void operator()(const f32x4 (&acc)[2][2][4][2], const pg8::Unit& u, int wr, int wc, int fr, int fq) const {
        const int row0 = u.pm * 256 + wr * 64 + fr, pn = u.pn, colb = wc * 32 + 8 * fq;
        f32x4 bv[2][2];
#pragma unroll
        for (int bj = 0; bj < 2; ++bj)
#pragma unroll
            for (int n = 0; n < 2; ++n) bv[bj][n] = (pn >= 14) ? *(const f32x4*)(b_gate + (pn * 256 + bj * 128 + colb - 3584) + 4 * n) * -1.4426950408889634f : (f32x4){0.f, 0.f, 0.f, 0.f};
#pragma unroll
        for (int ai = 0; ai < 2; ++ai)
#pragma unroll
            for (int m = 0; m < 4; ++m) {
                const int row = row0 + ai * 128 + m * 16; const float rs = rstd[row] * ((pn >= 14) ? (1.f / 64.f) : 1.f);
#pragma unroll
                for (int bj = 0; bj < 2; ++bj) {
                    const int col = pn * 256 + bj * 128 + colb;
                    f32x4 v0 = acc[ai][bj][m][0] * rs, v1 = acc[ai][bj][m][1] * rs; bf16* dst;
                    if (pn < 2) { dst = U5 + ((size_t)(col >> 4) * NCH + (row >> 5)) * S5KT + (row & 31) * 16 + (col & 15); }
                    else if (pn < 8) { dst = XL + (size_t)row * LW + (col - 512); }
                    else if (pn < 14) { dst = GY + (size_t)row * LW + (col - 2048);
#pragma unroll
                        for (int e = 0; e < 4; ++e) { v0[e] = fgelu(v0[e]); v1[e] = fgelu(v1[e]); } }
                    else {
                        const float nrs = rs * -1.4426950408889634f; u32x2 wq; wq.x = 0u; wq.y = 0u;
#pragma unroll
                        for (int e = 0; e < 4; ++e) {
                            const float g0 = __builtin_amdgcn_rcpf(1.f + __builtin_amdgcn_exp2f(__builtin_fmaf(acc[ai][bj][m][0][e], nrs, bv[bj][0][e])));
                            const float g1 = __builtin_amdgcn_rcpf(1.f + __builtin_amdgcn_exp2f(__builtin_fmaf(acc[ai][bj][m][1][e], nrs, bv[bj][1][e])));
                            wq.x = __builtin_amdgcn_cvt_pk_u8_f32(fmaxf(__builtin_fmaf(g0, GSC, 0.5f), 1.f), e, wq.x); wq.y = __builtin_amdgcn_cvt_pk_u8_f32(fmaxf(__builtin_fmaf(g1, GSC, 0.5f), 1.f), e, wq.y); }
                        *(u32x2*)((unsigned char*)GATES + (size_t)row * 4096 + (col - 3584)) = wq; continue; }
                    u32x4 w; w.x = cvt_pk_bf16(v0[0], v0[1]); w.y = cvt_pk_bf16(v0[2], v0[3]); w.z = cvt_pk_bf16(v1[0], v1[1]); w.w = cvt_pk_bf16(v1[2], v1[3]);
                    *(u32x4*)dst = w;
                }
            }
    }
};


struct Fp8Order {
    static constexpr bool GATHER = false;
    pg8::PlainOrder po; int w0, wstep, wn;
    __device__ bool next(int i, pg8::Unit& u) const { if (i >= wn || !po.next_L(w0 + i * wstep, u)) return false; u.pn += 14; return true; }
    __device__ __forceinline__ void a_offsets(const pg8::Unit&, const int (&)[2], const int (&)[2], unsigned (&)[2][2]) const {}
    __device__ __forceinline__ void a_ready(const pg8::Unit&) const {}
    __device__ __forceinline__ void done(const pg8::Unit&) const {}
};

struct S5EOrder {
    static constexpr bool GATHER = false;
    int G, c, lim; const char* A; const char* B;
    __device__ bool next(int i, pg8::Unit& u) const {
        const int L = i * G + c; if (L >= lim) return false;
        const int g = L >> 1; u.pm = L & 1; u.pn = 0; u.aux = g; u.nt = S5KU / 64;
        u.A = A + ((size_t)(g * NCH + 256 * u.pm) * S5KT) * 2; u.B = B + (size_t)g * 128 * S5KU * 2; return true; }
    __device__ __forceinline__ void a_offsets(const pg8::Unit&, const int (&)[2], const int (&)[2], unsigned (&)[2][2]) const {}
    __device__ __forceinline__ void a_ready(const pg8::Unit&) const {}
    __device__ __forceinline__ void done(const pg8::Unit&) const {}
};
struct EpiS5E {
    static constexpr bool PERM = false; static constexpr bool KEEP = false;
    float* SEND;
    __device__ __forceinline__ void operator()(const f32x4 (&acc)[2][2][4][2], const pg8::Unit& u, int wr, int wc, int fr, int fq) const {
        const int row0 = u.pm * 256 + wr * 64 + fr, col0 = wc * 32 + 4 * fq;
#pragma unroll
        for (int ai = 0; ai < 2; ++ai)
#pragma unroll
            for (int m = 0; m < 4; ++m) { float* rp = SEND + ((size_t)u.aux * NCH + row0 + ai * 128 + m * 16) * 128 + col0;
#pragma unroll
                for (int n = 0; n < 2; ++n) *(f32x4*)(rp + n * 16) = acc[ai][0][m][n]; }
    }
};
struct S5COrder {
    static constexpr bool GATHER = false;
    int G, c, lim; const char* A; const char* B;
    __device__ bool next(int i, pg8::Unit& u) const {
        const int L = i * G + c; if (L >= lim) return false;
        const int g = L >> 2; u.pm = (L >> 1) & 1; u.pn = L & 1; u.aux = g; u.nt = S5KT / 64;
        u.A = A + ((size_t)(g * NCH + 256 * u.pm) * S5KT) * 2; u.B = B + ((size_t)(g * S5KU + 256 * u.pn) * S5KT) * 2; return true; }
    __device__ __forceinline__ void a_offsets(const pg8::Unit&, const int (&)[2], const int (&)[2], unsigned (&)[2][2]) const {}
    __device__ __forceinline__ void a_ready(const pg8::Unit&) const {}
    __device__ __forceinline__ void done(const pg8::Unit&) const {}
};
struct EpiS5C {
    static constexpr bool PERM = true; static constexpr bool KEEP = false;
    const bf16* U5X; const float* dskip; bf16* Y5;
    __device__ __forceinline__ void operator()(const f32x4 (&acc)[2][2][4][2], const pg8::Unit& u, int wr, int wc, int fr, int fq) const {
        const int g = u.aux, row0 = u.pm * 256 + wr * 64 + fr, colb = u.pn * 256 + wc * 32 + 8 * fq;
#pragma unroll
        for (int bj = 0; bj < 2; ++bj) {
            const int n0 = colb + bj * 128, ti = n0 >> 4, c0 = n0 & 15;
            const f32x4 d0 = *(const f32x4*)(dskip + g * 16 + c0), d1 = *(const f32x4*)(dskip + g * 16 + c0 + 4);
            u32x4 uw[2][4];
#pragma unroll
            for (int ai = 0; ai < 2; ++ai)
#pragma unroll
                for (int m = 0; m < 4; ++m) uw[ai][m] = *(const u32x4*)(U5X + ((size_t)g * NCH + row0 + ai * 128 + m * 16) * S5KT + n0);
#pragma unroll
            for (int ai = 0; ai < 2; ++ai)
#pragma unroll
                for (int m = 0; m < 4; ++m) {
                    const int j = row0 + ai * 128 + m * 16;
                    f32x4 u0, u1; unpack8(uw[ai][m], u0, u1);
                    f32x4 v0 = acc[ai][bj][m][0] + d0 * u0, v1 = acc[ai][bj][m][1] + d1 * u1;
#pragma unroll
                    for (int e = 0; e < 4; ++e) { v0[e] = fgelu(v0[e]); v1[e] = fgelu(v1[e]); }
                    u32x4 w; w.x = cvt_pk_bf16(v0[0], v0[1]); w.y = cvt_pk_bf16(v0[2], v0[3]); w.z = cvt_pk_bf16(v1[0], v1[1]); w.w = cvt_pk_bf16(v1[2], v1[3]);
                    *(u32x4*)(Y5 + (size_t)(j * LC + ti) * S5W + g * 16 + c0) = w;
                }
            asm volatile("" ::: "memory");
        }
    }
};
struct EpiGlu {
    static constexpr bool PERM = true; static constexpr bool KEEP = false;
    const bf16* Y5; const float* bias; bf16* OUTC;
    __device__ __forceinline__ void operator()(const f32x4 (&acc)[2][2][4][2], const pg8::Unit& u, int wr, int wc, int fr, int fq) const {
        const int row0 = u.pm * 256 + wr * 64 + fr, colb = u.pn * 256 + wc * 32 + 8 * fq;
#pragma unroll
        for (int bj = 0; bj < 2; ++bj) {
            const int col = colb + bj * 128;
            const f32x4 b0 = *(const f32x4*)(bias + col), b1 = *(const f32x4*)(bias + col + 4);
            u32x4 yw[2][4];
#pragma unroll
            for (int ai = 0; ai < 2; ++ai)
#pragma unroll
                for (int m = 0; m < 4; ++m) yw[ai][m] = *(const u32x4*)(Y5 + (size_t)(row0 + ai * 128 + m * 16) * S5W + col);
#pragma unroll
            for (int ai = 0; ai < 2; ++ai)
#pragma unroll
                for (int m = 0; m < 4; ++m) {
                    f32x4 y0, y1; unpack8(yw[ai][m], y0, y1);
                    f32x4 v0 = acc[ai][bj][m][0] + b0, v1 = acc[ai][bj][m][1] + b1;
#pragma unroll
                    for (int e = 0; e < 4; ++e) { v0[e] = y0[e] * fsig(v0[e]); v1[e] = y1[e] * fsig(v1[e]); }
                    u32x2 w; { unsigned w_ = 0; w_ = F8PK(v0[0] * 16.f, v0[1] * 16.f, w_, false); w_ = F8PK(v0[2] * 16.f, v0[3] * 16.f, w_, true); w.x = w_; }
                    { unsigned w_ = 0; w_ = F8PK(v1[0] * 16.f, v1[1] * 16.f, w_, false); w_ = F8PK(v1[2] * 16.f, v1[3] * 16.f, w_, true); w.y = w_; }
                    *(u32x2*)((unsigned char*)OUTC + (size_t)(row0 + ai * 128 + m * 16) * D + col) = w;
                }
            asm volatile("" ::: "memory");
        }
    }
};

struct EpiProj {
    static constexpr bool PERM = true; static constexpr bool KEEP = true;
    const bf16* GATES; bf16* MERGED;
    __device__ __forceinline__ void operator()(f32x4 (&acc)[2][2][4][2], const pg8::Unit& u, int wr, int wc, int fr, int fq) const {
        const int row0 = u.pm * 256 + wr * 64 + fr, colb = u.pn * 256 + wc * 32 + 8 * fq;
        if (u.aux == 0) {
#pragma unroll
            for (int ai = 0; ai < 2; ++ai)
#pragma unroll
                for (int mh = 0; mh < 2; ++mh) {
                    u32x2 sw[2][2], lw[2][2];
#pragma unroll
                    for (int mm = 0; mm < 2; ++mm)
#pragma unroll
                        for (int bj = 0; bj < 2; ++bj) { const unsigned char* gp = (const unsigned char*)GATES + (size_t)(row0 + ai * 128 + (2 * mh + mm) * 16) * 4096 + colb + bj * 128; sw[mm][bj] = *(const u32x2*)gp; lw[mm][bj] = *(const u32x2*)(gp + 2048); }
#pragma unroll
                    for (int mm = 0; mm < 2; ++mm)
#pragma unroll
                        for (int bj = 0; bj < 2; ++bj) { const int m = 2 * mh + mm; f32x4 s0, s1, l0, l1; unpack8u(sw[mm][bj], s0, s1); unpack8u(lw[mm][bj], l0, l1);
#pragma unroll
                            for (int e = 0; e < 4; ++e) { acc[ai][bj][m][0][e] *= s0[e] * __builtin_amdgcn_rcpf(l0[e]); acc[ai][bj][m][1][e] *= s1[e] * __builtin_amdgcn_rcpf(l1[e]); } }
                    asm volatile("" ::: "memory"); }
            return; }
#pragma unroll
        for (int ai = 0; ai < 2; ++ai) {
            u32x2 lw[4][2];
#pragma unroll
            for (int m = 0; m < 4; ++m)
#pragma unroll
                for (int bj = 0; bj < 2; ++bj) lw[m][bj] = *(const u32x2*)((const unsigned char*)GATES + (size_t)(row0 + ai * 128 + m * 16) * 4096 + 2048 + colb + bj * 128);
#pragma unroll
            for (int m = 0; m < 4; ++m)
#pragma unroll
                for (int bj = 0; bj < 2; ++bj) { f32x4 l0, l1; unpack8u(lw[m][bj], l0, l1);
                    const f32x4 v0 = acc[ai][bj][m][0] * l0 * (1.f / (64.f * GSC)), v1 = acc[ai][bj][m][1] * l1 * (1.f / (64.f * GSC));
                    u32x2 w; { unsigned w_ = 0; w_ = F8PK(v0[0], v0[1], w_, false); w_ = F8PK(v0[2], v0[3], w_, true); w.x = w_; }
                    { unsigned w_ = 0; w_ = F8PK(v1[0], v1[1], w_, false); w_ = F8PK(v1[2], v1[3], w_, true); w.y = w_; }
                    *(u32x2*)((unsigned char*)MERGED + (size_t)(row0 + ai * 128 + m * 16) * D + colb + bj * 128) = w; }
            asm volatile("" ::: "memory"); }
    }
};
struct ProjOrder {
    static constexpr bool GATHER = false;
    pg8::PlainOrder po;
    __device__ bool next(int i, pg8::Unit& u) const {
        if (!po.next(i >> 1, u)) return false;
        if (i & 1) { u.A += S5W; u.B += S5W; u.nt = LW / 128; u.aux = 1; } else { u.nt = S5W / 128; u.aux = 0; }
        return true; }
    __device__ __forceinline__ void a_offsets(const pg8::Unit&, const int (&)[2], const int (&)[2], unsigned (&)[2][2]) const {}
    __device__ __forceinline__ void a_ready(const pg8::Unit&) const {}
    __device__ __forceinline__ void done(const pg8::Unit&) const {}
};
struct EpiWout {
    static constexpr bool PERM = true; static constexpr bool KEEP = false;
    bf16* DELTA; const bf16* XB;
    __device__ __forceinline__ void operator()(const f32x4 (&acc)[2][2][4][2], const pg8::Unit& u, int wr, int wc, int fr, int fq) const {
        const int row0 = u.pm * 256 + wr * 64 + fr, col0 = u.pn * 256 + wc * 32 + 8 * fq;
#pragma unroll
        for (int ai = 0; ai < 2; ++ai)
#pragma unroll
            for (int m = 0; m < 4; ++m)
#pragma unroll
                for (int bj = 0; bj < 2; ++bj) { f32x4 x0, x1; unpack8(*(const u32x4*)(XB + (size_t)(row0 + ai * 128 + m * 16) * D + col0 + bj * 128), x0, x1);
                    const f32x4 v0 = acc[ai][bj][m][0] * (1.f / 1024.f) + x0, v1 = acc[ai][bj][m][1] * (1.f / 1024.f) + x1;
                    u32x4 w; w.x = cvt_pk_bf16(v0[0], v0[1]); w.y = cvt_pk_bf16(v0[2], v0[3]); w.z = cvt_pk_bf16(v1[0], v1[1]); w.w = cvt_pk_bf16(v1[2], v1[3]);
                    *(u32x4*)(DELTA + (size_t)(row0 + ai * 128 + m * 16) * D + col0 + bj * 128) = w; }
    }
};

__device__ __forceinline__ void s5_tables(const P& p, LAS f32x2* LPW, LAS f32x2* CC, LAS f32x2* BB, int g, int tid) {
    const float step = expf(p.s5_log_step[g]);
#pragma unroll 1
    for (int e = tid; e < (LC + 1) * 64; e += 512) { const int d = e >> 6, pp = e & 63;
        const float lre = p.s5_lam_re[g * S5P + pp], lim = p.s5_lam_im[g * S5P + pp];
        const float er = expf((float)d * lre * step); float sn, cs; sincosf((float)d * lim * step, &sn, &cs);
        LPW[e] = (f32x2){er * cs, er * sn}; }
#pragma unroll 1
    for (int e = tid; e < 1024; e += 512) {
        {   const int pp = e >> 4, c = e & 15;
            const float lre = p.s5_lam_re[g * S5P + pp], lim = p.s5_lam_im[g * S5P + pp];
            const float er = expf(lre * step); float sn, cs; sincosf(lim * step, &sn, &cs);
            const float nr = er * cs - 1.f, ni = er * sn, den = lre * lre + lim * lim;
            const float cr = (nr * lre + ni * lim) / den, ci = (ni * lre - nr * lim) / den;
            const float br = p.s5_b_re[((size_t)g * S5P + pp) * 16 + c], bi = p.s5_b_im[((size_t)g * S5P + pp) * 16 + c];
            BB[e] = (f32x2){cr * br - ci * bi, cr * bi + ci * br}; }
        {   const int c = e >> 6, pp = e & 63;
            CC[e] = (f32x2){p.s5_c_re[((size_t)g * 16 + c) * S5P + pp], p.s5_c_im[((size_t)g * 16 + c) * S5P + pp]}; }
    }
    __syncthreads();
}
__device__ __forceinline__ void p0_s5_kt(const P& p, LAS unsigned char* lds, int g, int part, int tid) {
    LAS f32x2* LPW = (LAS f32x2*)lds; LAS f32x2* CC = LPW + (LC + 1) * 64; LAS f32x2* BB = CC + 16 * 64;
    s5_tables(p, LPW, CC, BB, g, tid);
    float* KTG = (float*)(p.ws + WS_KTG) + (size_t)g * LC * 256;
    for (int e = tid; e < 4 * 256; e += 512) { const int d = 4 * part + (e >> 8), c = (e >> 4) & 15, c2 = e & 15; float acc = 0.f;
#pragma unroll 4
        for (int pp = 0; pp < 64; ++pp) { const f32x2 cc = CC[c * 64 + pp], lp = LPW[d * 64 + pp], bb = BB[pp * 16 + c2];
            const float wr_ = cc.x * lp.x - cc.y * lp.y, wi_ = cc.x * lp.y + cc.y * lp.x;
            acc += wr_ * bb.x - wi_ * bb.y; }
        KTG[d * 256 + c * 16 + c2] = acc; }
    __syncthreads();
}
__device__ __forceinline__ void p0_s5_build(const P& p, LAS unsigned char* lds, int g, int part, int tid) {
    LAS f32x2* LPW = (LAS f32x2*)lds;
    LAS f32x2* CC  = LPW + (LC + 1) * 64;
    LAS f32x2* BB  = CC + 16 * 64;
    LAS float* KT  = (LAS float*)(BB + 64 * 16);
    {   const f32x4* KTG = (const f32x4*)((const float*)(p.ws + WS_KTG) + (size_t)g * LC * 256);
        for (int e = tid; e < LC * 64; e += 512) ((LAS f32x4*)KT)[e] = KTG[e]; }
    s5_tables(p, LPW, CC, BB, g, tid);
    const int wave = tid >> 6, lane = tid & 63;
    bf16* BtY = (bf16*)(p.ws + WS_BTY) + (size_t)g * S5KU * S5KT;
    for (int rr = 0; rr < 8; ++rr) {
        const int n = 64 * part + 8 * wave + rr, i = n >> 4, c = n & 15;
        for (int ch = lane; ch < S5KT / 8; ch += 64) {
            const int k0 = 8 * ch; float v[8];
            if (k0 < S5KU) { const int i2 = k0 >> 4, c0 = k0 & 15;
#pragma unroll
                for (int e = 0; e < 8; ++e) v[e] = (i2 <= i) ? KT[((i - i2) * 16 + c) * 16 + c0 + e] : 0.f; }
            else { const int q0 = k0 - S5KU; const bool im = q0 >= 64; const int p0 = q0 & 63;
#pragma unroll
                for (int e = 0; e < 8; ++e) { const f32x2 cc = CC[c * 64 + p0 + e], lp = LPW[(i + 1) * 64 + p0 + e];
                    v[e] = im ? -(cc.x * lp.y + cc.y * lp.x) : (cc.x * lp.x - cc.y * lp.y); } }
            u32x4 o; o.x = cvt_pk_bf16(v[0], v[1]); o.y = cvt_pk_bf16(v[2], v[3]); o.z = cvt_pk_bf16(v[4], v[5]); o.w = cvt_pk_bf16(v[6], v[7]);
            *(GAS u32x4*)(BtY + (size_t)n * S5KT + k0) = o;
        }
    }
    bf16* BtE = (bf16*)(p.ws + WS_BTE) + (size_t)g * 128 * S5KU;
    for (int rr = 0; rr < 2; ++rr) {
        const int r = 16 * part + 2 * wave + rr; const bool im = r >= 64; const int pp = r & 63;
        const int k0 = 8 * lane, i2 = k0 >> 4, c0 = k0 & 15; float v[8];
        const f32x2 lp = LPW[(LC - 1 - i2) * 64 + pp];
#pragma unroll
        for (int e = 0; e < 8; ++e) { const f32x2 bb = BB[pp * 16 + c0 + e]; v[e] = im ? (lp.x * bb.y + lp.y * bb.x) : (lp.x * bb.x - lp.y * bb.y); }
        u32x4 o; o.x = cvt_pk_bf16(v[0], v[1]); o.y = cvt_pk_bf16(v[2], v[3]); o.z = cvt_pk_bf16(v[4], v[5]); o.w = cvt_pk_bf16(v[6], v[7]);
        *(GAS u32x4*)(BtE + (size_t)r * S5KU + k0) = o;
    }
    if (part == 0 && tid < 64) ((f32x2*)(p.ws + WS_LAML))[g * 64 + tid] = LPW[LC * 64 + tid];
    __syncthreads();
}

template <int PASS, bool FUSED = false> __device__ __forceinline__ void lru_pass(const P& p, LAS unsigned char* lds, int G, int bx, int tid, int lane, int wave, int nbusy, int xtra) {
    const int h = bx % LH, q = bx / LH, nblk = (G - h + LH - 1) / LH, nq1 = (nbusy > h) ? ((nbusy - h + LH - 1) / LH < nblk ? (nbusy - h + LH - 1) / LH : nblk) : 0, n2 = nblk - nq1;
    const bool busy = q < nq1; const int R0 = xtra * n2;
#define LRU_TILE(k) (busy ? (R0 + (k) * nblk + q) : ((k) < xtra ? ((k) * n2 + (q - nq1)) : (R0 + ((k) - xtra) * nblk + q)))
    LAS float* RL = (LAS float*)lds; LAS float* IL = RL + LTT * 132;
    LAS bf16* XCB = (LAS bf16*)(lds + 3 * LTT * 128 * 4); LAS f32x2* SEG = (LAS f32x2*)(lds + 3 * LTT * 128 * 4 + LTT * 136 * 2);
    const bf16* XLg = (const bf16*)(p.ws + WS_XL); const bf16* GYg = (const bf16*)(p.ws + WS_GY); bf16* OC = (bf16*)(p.ws + WS_OUTC);
    const int j = tid & 127, s = tid >> 7, ch = h * LHD + j;
    const float cw0 = p.lru_conv_w[0 * LW + ch], cw1 = p.lru_conv_w[1 * LW + ch], cw2 = p.lru_conv_w[2 * LW + ch], cw3 = p.lru_conv_w[3 * LW + ch], cb = p.lru_conv_b[ch];
    const float nba = -1.4426950408889634f * p.lru_b_a[ch], nbx = -1.4426950408889634f * p.lru_b_x[ch];
    const float lam = p.lru_lambda[ch];
    const float sp8 = -8.f * 1.4426950408889634f * ((-lam > 20.f) ? -lam : log1pf(expf(-lam)));
    const int gate = wave >> 2, cb0 = (wave & 3) * 32, fr = lane & 15, fq = lane >> 4;
    const bf16* WL = (const bf16*)(p.ws + WS_WLT) + (size_t)h * 256 * 128;
    bf16x8 Bf[2][4];
#pragma unroll
    for (int nb = 0; nb < 2; ++nb)
#pragma unroll
        for (int ks = 0; ks < 4; ++ks) Bf[nb][ks] = *(const bf16x8*)(WL + (size_t)(gate * 128 + cb0 + 16 * nb + fr) * 128 + ks * 32 + 8 * fq);
    bf16 xs[19], xn[19], gs[16], gn[16]; float hin = 0.f, hinn = 0.f;
    const int kidx = LRU_TILE(0);
    if (kidx < LNT) { const int tb = kidx * LTT + 16 * s;
#pragma unroll
        for (int i = 0; i < 19; ++i) xs[i] = (tb - 3 + i >= 0) ? XLg[(size_t)(tb - 3 + i) * LW + ch] : (bf16)0;
        if (PASS == 1) {
#pragma unroll
            for (int i = 0; i < 16; ++i) gs[i] = GYg[(size_t)(tb + i) * LW + ch];
            if (!FUSED) hin = ((const float*)(p.ws + WS_HIN))[(size_t)kidx * LW + ch]; } }
    for (int kk = 0; ; ++kk) {
        const int tt = LRU_TILE(kk); if (tt >= LNT) break;
        const int t0 = tt * LTT, tb = t0 + 16 * s; const int tn = LRU_TILE(kk + 1);
        if (FUSED && PASS == 1) {
            const LAS f32x2* PRE = (const LAS f32x2*)(lds + LRU_PRE_OFF); const LAS f32x2* SG4 = (const LAS f32x2*)(lds + LRU_SG4_OFF);
            const f32x2 pr = PRE[kk * 128 + j]; const int qd = tt >> 6; float c = 0.f;
#pragma unroll
            for (int d = 0; d < 3; ++d) { const f32x2 sg = SG4[d * 128 + j]; if (d < qd) c = sg.x * c + sg.y; }
            hin = pr.x * c + pr.y; }
        float xcv[16];
        {
            float x0 = bf2f(xs[0]), x1 = bf2f(xs[1]), x2 = bf2f(xs[2]);
#pragma unroll
            for (int i = 0; i < 16; ++i) { const float x3 = bf2f(xs[3 + i]);
                const float xc = cb + cw0 * x0 + cw1 * x1 + cw2 * x2 + cw3 * x3; x0 = x1; x1 = x2; x2 = x3;
                xcv[i] = xc; XCB[(16 * s + i) * 136 + j] = (bf16)cvt_pk_bf16(xc, xc); }
        }
        if (tn < LNT) { const int tbn = tn * LTT + 16 * s;
#pragma unroll
            for (int i = 0; i < 19; ++i) xn[i] = XLg[(size_t)(tbn - 3 + i) * LW + ch];
            if (PASS == 1) {
#pragma unroll
                for (int i = 0; i < 16; ++i) gn[i] = GYg[(size_t)(tbn + i) * LW + ch];
                if (!FUSED) hinn = ((const float*)(p.ws + WS_HIN))[(size_t)tn * LW + ch]; } }
        __syncthreads();
        {
            f32x4 acc[4][2];
#pragma unroll
            for (int mb = 0; mb < 4; ++mb) { acc[mb][0] = (f32x4){0.f, 0.f, 0.f, 0.f}; acc[mb][1] = (f32x4){0.f, 0.f, 0.f, 0.f}; }
#pragma unroll
            for (int mb = 0; mb < 4; ++mb)
#pragma unroll
                for (int ks = 0; ks < 4; ++ks) { const bf16x8 a = *(const LAS bf16x8*)(XCB + (16 * mb + fr) * 136 + ks * 32 + 8 * fq);
                    acc[mb][0] = __builtin_amdgcn_mfma_f32_16x16x32_bf16(a, Bf[0][ks], acc[mb][0], 0, 0, 0);
                    acc[mb][1] = __builtin_amdgcn_mfma_f32_16x16x32_bf16(a, Bf[1][ks], acc[mb][1], 0, 0, 0); }
            LAS float* OL = gate ? IL : RL;
#pragma unroll
            for (int mb = 0; mb < 4; ++mb)
#pragma unroll
                for (int nb = 0; nb < 2; ++nb)
#pragma unroll
                    for (int r = 0; r < 4; ++r) OL[(16 * mb + 4 * fq + r) * 132 + cb0 + 16 * nb + fr] = acc[mb][nb][r];
        }
        __syncthreads();
        float av[16], bv[16]; float Ap = 1.f, Hp = 0.f;
        float zr[16], zi[16];
#pragma unroll
        for (int i = 0; i < 16; ++i) { zr[i] = RL[(16 * s + i) * 132 + j]; zi[i] = IL[(16 * s + i) * 132 + j]; }
        asm volatile("s_waitcnt lgkmcnt(0)" ::: "memory");
#pragma unroll
        for (int i = 0; i < 16; ++i) {
            const float r = __builtin_amdgcn_rcpf(1.f + __builtin_amdgcn_exp2f(__builtin_fmaf(zr[i], -1.4426950408889634f, nba)));
            const float ig = __builtin_amdgcn_rcpf(1.f + __builtin_amdgcn_exp2f(__builtin_fmaf(zi[i], -1.4426950408889634f, nbx)));
            const float a = __builtin_amdgcn_exp2f(sp8 * r);
            float mult = __builtin_amdgcn_sqrtf(__builtin_fmaf(-a, a, 1.f));
            if (i == 0) mult = (t0 + 16 * s == 0) ? 1.f : mult;
            const float bb = xcv[i] * ig * mult;
            av[i] = a; bv[i] = bb; Hp = a * Hp + bb; Ap *= a; }
        SEG[s * 128 + j] = (f32x2){Ap, Hp};
        __syncthreads();
        if (PASS == 0) {
            if (s == 0) { float A = 1.f, H = 0.f;
#pragma unroll
                for (int q = 0; q < 4; ++q) { const f32x2 sg = SEG[q * 128 + j]; H = sg.x * H + sg.y; A *= sg.x; }
                if (FUSED) __hip_atomic_store((unsigned long long*)(p.ws + WS_AG) + (size_t)tt * LW + ch, __builtin_bit_cast(unsigned long long, (f32x2){A, H}), __ATOMIC_RELAXED, __HIP_MEMORY_SCOPE_AGENT);
                else ((f32x2*)(p.ws + WS_AG))[(size_t)tt * LW + ch] = (f32x2){A, H}; }
        } else {
            float hc = hin;
#pragma unroll
            for (int q = 0; q < 3; ++q) { const f32x2 sg = SEG[q * 128 + j]; if (q < s) hc = sg.x * hc + sg.y; }
#pragma unroll
            for (int i = 0; i < 16; ++i) { hc = av[i] * hc + bv[i]; ((unsigned char*)OC)[(size_t)(tb + i) * D + S5W + ch] = (unsigned char)F8PK(hc * bf2f(gs[i]) * 16.f, 0.f, 0u, false); }
        }
#pragma unroll
        for (int i = 0; i < 19; ++i) xs[i] = xn[i];
        if (PASS == 1) {
#pragma unroll
            for (int i = 0; i < 16; ++i) gs[i] = gn[i];
            if (!FUSED) hin = hinn; }
    }
    __syncthreads();
#undef LRU_TILE
}

constexpr int CW_LH = 32768;
__device__ __forceinline__ void lru_mid(const P& p, LAS unsigned char* lds, unsigned* ctl, int li, int GL, int bl, int tid) {
    const int h = bl % LH, q = bl / LH, nblk = (GL - h + LH - 1) / LH;
    const int j = tid & 127, s = tid >> 7, ch = h * LHD + j;
    unsigned* cnt = ctl + CW_LH + li * 1024 + 64 * h;
    asm volatile("s_waitcnt vmcnt(0)" ::: "memory");
    if ((tid & 63) == 0) __hip_atomic_fetch_add(cnt, 1u, __ATOMIC_RELAXED, __HIP_MEMORY_SCOPE_AGENT);
    if (tid < 64) { unsigned sp = 0; const int want = nblk * NWAVES;
        while ((int)__builtin_amdgcn_readfirstlane(__hip_atomic_load(cnt, __ATOMIC_RELAXED, __HIP_MEMORY_SCOPE_AGENT)) < want) { __builtin_amdgcn_s_sleep(2); if (++sp > (1u << 22)) break; }
        __builtin_amdgcn_fence(__ATOMIC_ACQUIRE, "agent");
        asm volatile("s_waitcnt vmcnt(0)" ::: "memory"); }
    __syncthreads();
    LAS f32x2* PRE = (LAS f32x2*)(lds + LRU_PRE_OFF); LAS f32x2* SG4 = (LAS f32x2*)(lds + LRU_SG4_OFF);
    const f32x2* AGh = (const f32x2*)(p.ws + WS_AG) + (size_t)(64 * s) * LW + ch;
    int k = (64 * s <= q) ? 0 : (64 * s - q + nblk - 1) / nblk; int nxt = q + k * nblk - 64 * s;
    float A = 1.f, H = 0.f; f32x2 va[16], vb[16];
#pragma unroll
    for (int i = 0; i < 16; ++i) va[i] = AGh[(size_t)i * LW];
#pragma unroll
    for (int i = 0; i < 16; ++i) vb[i] = AGh[(size_t)(16 + i) * LW];
#pragma unroll
    for (int i = 0; i < 16; ++i) { if (i == nxt) { PRE[k * 128 + j] = (f32x2){A, H}; ++k; nxt += nblk; } H = va[i].x * H + va[i].y; A *= va[i].x; }
#pragma unroll
    for (int i = 0; i < 16; ++i) va[i] = AGh[(size_t)(32 + i) * LW];
#pragma unroll
    for (int i = 0; i < 16; ++i) { if (16 + i == nxt) { PRE[k * 128 + j] = (f32x2){A, H}; ++k; nxt += nblk; } H = vb[i].x * H + vb[i].y; A *= vb[i].x; }
#pragma unroll
    for (int i = 0; i < 16; ++i) vb[i] = AGh[(size_t)(48 + i) * LW];
#pragma unroll
    for (int i = 0; i < 16; ++i) { if (32 + i == nxt) { PRE[k * 128 + j] = (f32x2){A, H}; ++k; nxt += nblk; } H = va[i].x * H + va[i].y; A *= va[i].x; }
#pragma unroll
    for (int i = 0; i < 16; ++i) { if (48 + i == nxt) { PRE[k * 128 + j] = (f32x2){A, H}; ++k; nxt += nblk; } H = vb[i].x * H + vb[i].y; A *= vb[i].x; }
    SG4[s * 128 + j] = (f32x2){A, H};
    __syncthreads();
}

__device__ __forceinline__ void scan_lru(const P& p, int w, int lane) {
    const int ch = 64 * w + lane; const f32x2* AG = (const f32x2*)(p.ws + WS_AG); float* HIN = (float*)(p.ws + WS_HIN);
    float hc = 0.f; f32x2 a[8], b[8];
#pragma unroll
    for (int q = 0; q < 8; ++q) a[q] = AG[(size_t)q * LW + ch];
    for (int tt = 0; tt < LNT; tt += 16) {
#pragma unroll
        for (int q = 0; q < 8; ++q) b[q] = AG[(size_t)(tt + 8 + q) * LW + ch];
#pragma unroll
        for (int q = 0; q < 8; ++q) { HIN[(size_t)(tt + q) * LW + ch] = hc; hc = a[q].x * hc + a[q].y; }
        if (tt + 16 < LNT) {
#pragma unroll
            for (int q = 0; q < 8; ++q) a[q] = AG[(size_t)(tt + 16 + q) * LW + ch]; }
#pragma unroll
        for (int q = 0; q < 8; ++q) { HIN[(size_t)(tt + 8 + q) * LW + ch] = hc; hc = b[q].x * hc + b[q].y; }
    }
}
__device__ __forceinline__ void scan_s5(const P& p, int g, int lane) {
    const f32x2 lam = ((const f32x2*)(p.ws + WS_LAML))[g * 64 + lane];
    const float* SE = (const float*)(p.ws + WS_SEND) + (size_t)g * NCH * 128; bf16* UX = (bf16*)(p.ws + WS_U5X) + (size_t)g * NCH * S5KT;
    float sr = 0.f, si = 0.f; float er[8], ei[8], fr_[8], fi_[8];
#pragma unroll
    for (int q = 0; q < 8; ++q) { er[q] = SE[(size_t)q * 128 + lane]; ei[q] = SE[(size_t)q * 128 + 64 + lane]; }
    for (int jc = 0; jc < NCH; jc += 16) {
#pragma unroll
        for (int q = 0; q < 8; ++q) { fr_[q] = SE[(size_t)(jc + 8 + q) * 128 + lane]; fi_[q] = SE[(size_t)(jc + 8 + q) * 128 + 64 + lane]; }
#pragma unroll
        for (int q = 0; q < 8; ++q) { UX[(size_t)(jc + q) * S5KT + S5KU + lane] = f2bf(sr); UX[(size_t)(jc + q) * S5KT + S5KU + 64 + lane] = f2bf(si);
            const float nr = lam.x * sr - lam.y * si + er[q], ni = lam.x * si + lam.y * sr + ei[q]; sr = nr; si = ni; }
        if (jc + 16 < NCH) {
#pragma unroll
            for (int q = 0; q < 8; ++q) { er[q] = SE[(size_t)(jc + 16 + q) * 128 + lane]; ei[q] = SE[(size_t)(jc + 16 + q) * 128 + 64 + lane]; } }
#pragma unroll
        for (int q = 0; q < 8; ++q) { UX[(size_t)(jc + 8 + q) * S5KT + S5KU + lane] = f2bf(sr); UX[(size_t)(jc + 8 + q) * S5KT + S5KU + 64 + lane] = f2bf(si);
            const float nr = lam.x * sr - lam.y * si + fr_[q], ni = lam.x * si + lam.y * sr + fi_[q]; sr = nr; si = ni; }
    }
}


constexpr int CW_ECNT = 16384;
constexpr int ECNT_OFF = MISC_OFF + 128;
__device__ __forceinline__ void router_phase(const P& p, LAS unsigned char* lds, int G, int bx, int tid, int lane, int wave, bool dry) {
    LAS float* PL = (LAS float*)lds;
    LAS unsigned* HC = (LAS unsigned*)(lds + 8 * 32 * 40 * 4);
    const bf16* WRH = (const bf16*)(p.ws + WS_WRH); const bf16* WRL = (const bf16*)(p.ws + WS_WRL); const bf16* WGH = (const bf16*)(p.ws + WS_WGH); const bf16* WGL = (const bf16*)(p.ws + WS_WGL);
    unsigned* gcount = (unsigned*)(p.ws + WS_CTL) + CW_ECNT;
    int* LISTI = (int*)(p.ws + WS_LISTI); float* LISTR = (float*)(p.ws + WS_LISTR); float* LISTW = (float*)(p.ws + WS_LISTW);
    const int tt = wave >> 2, kq = wave & 3, i = lane & 31, kh = lane >> 5;
    const bf16x8 zero8 = (bf16x8){0, 0, 0, 0, 0, 0, 0, 0};
#define RT_LOADX(X, it_) do { X[0] = *(const u32x4*)(dl + (it_) * 32); X[1] = *(const u32x4*)(dl + (it_) * 32 + 8); } while (0)
#define RT_LOAD(BH, BL, GH, GL, it_) do { \
        _Pragma("unroll") for (int u = 0; u < 2; ++u) { const size_t wo = ((size_t)(kq * 64 + (it_) * 4 + 2 * kh + u) * 32 + i) * 8; \
            BH[u] = *(const bf16x8*)(WRH + wo); BL[u] = *(const bf16x8*)(WRL + wo); GH[u] = zero8; GL[u] = zero8; \
            if (i < 4) { GH[u] = *(const bf16x8*)(WGH + wo); GL[u] = *(const bf16x8*)(WGL + wo); } } } while (0)
#define RT_STEP(XW, BH, BL, GH, GL, it_) do { \
        _Pragma("unroll") for (int u = 0; u < 2; ++u) { const bf16x8 a_ = __builtin_bit_cast(bf16x8, XW[u]); \
            acc = __builtin_amdgcn_mfma_f32_32x32x16_bf16(a_, BH[u], acc, 0, 0, 0); accg = __builtin_amdgcn_mfma_f32_32x32x16_bf16(a_, GH[u], accg, 0, 0, 0); \
            acc = __builtin_amdgcn_mfma_f32_32x32x16_bf16(a_, BL[u], acc, 0, 0, 0); accg = __builtin_amdgcn_mfma_f32_32x32x16_bf16(a_, GL[u], accg, 0, 0, 0); } \
        f32x4 X[4]; unpack8(XW[0], X[0], X[1]); unpack8(XW[1], X[2], X[3]); \
        { u32x4 w0; \
          { unsigned w_ = 0; w_ = F8PK(X[0][0], X[0][1], w_, false); w_ = F8PK(X[0][2], X[0][3], w_, true); w0.x = w_; } \
          { unsigned w_ = 0; w_ = F8PK(X[1][0], X[1][1], w_, false); w_ = F8PK(X[1][2], X[1][3], w_, true); w0.y = w_; } \
          { unsigned w_ = 0; w_ = F8PK(X[2][0], X[2][1], w_, false); w_ = F8PK(X[2][2], X[2][3], w_, true); w0.z = w_; } \
          { unsigned w_ = 0; w_ = F8PK(X[3][0], X[3][1], w_, false); w_ = F8PK(X[3][2], X[3][3], w_, true); w0.w = w_; } \
          if (!dry) *(u32x4*)(xb + (it_) * 32) = w0; } \
        _Pragma("unroll") for (int g4 = 0; g4 < 4; ++g4) _Pragma("unroll") for (int q = 0; q < 4; ++q) ss += X[g4][q] * X[g4][q]; } while (0)
    for (int tg = bx; tg < T / 64; tg += G) {
        if (tid < 32) HC[tid] = 0u;
        const size_t xoff = (size_t)(tg * 64 + tt * 32 + i) * D + kq * 512 + 16 * kh;
        const bf16* dl = (const bf16*)(p.ws + WS_DELTA) + xoff; unsigned char* xb = (unsigned char*)(p.ws + WS_X1B) + xoff;
        f32x16 acc;
#pragma unroll
        for (int r = 0; r < 16; ++r) acc[r] = 0.f;
        f32x16 accg;
#pragma unroll
        for (int r = 0; r < 16; ++r) accg[r] = 0.f;
        float ss = 0.f;
        u32x4 x0[2], x1_[2], x2[2], x3[2]; bf16x8 hA[2], lA[2], ghA[2], glA[2], hB[2], lB[2], ghB[2], glB[2];
        RT_LOADX(x0, 0); RT_LOADX(x1_, 1); RT_LOADX(x2, 2); RT_LOADX(x3, 3);
        RT_LOAD(hA, lA, ghA, glA, 0);
#pragma unroll 1
        for (int it = 0; it < 16; it += 4) {
            RT_LOAD(hB, lB, ghB, glB, it + 1);
            RT_STEP(x0, hA, lA, ghA, glA, it);
            if (it + 4 < 16) RT_LOADX(x0, it + 4);
            RT_LOAD(hA, lA, ghA, glA, it + 2);
            RT_STEP(x1_, hB, lB, ghB, glB, it + 1);
            if (it + 4 < 16) RT_LOADX(x1_, it + 5);
            RT_LOAD(hB, lB, ghB, glB, it + 3);
            RT_STEP(x2, hA, lA, ghA, glA, it + 2);
            if (it + 4 < 16) { RT_LOADX(x2, it + 6); RT_LOAD(hA, lA, ghA, glA, it + 4); }
            RT_STEP(x3, hB, lB, ghB, glB, it + 3);
            if (it + 4 < 16) RT_LOADX(x3, it + 7);
        }
#undef RT_LOADX
#undef RT_LOAD
#undef RT_STEP
        ss += __shfl_xor(ss, 32);
        LAS float* pw = PL + wave * 32 * 40;
#pragma unroll
        for (int r = 0; r < 16; ++r) pw[((r & 3) + 8 * (r >> 2) + 4 * kh) * 40 + 4 + i] = acc[r];
        if (i < 4) {
#pragma unroll
            for (int r = 0; r < 16; ++r) pw[((r & 3) + 8 * (r >> 2) + 4 * kh) * 40 + i] = accg[r]; }
        if (kh == 0) pw[i * 40 + 36] = ss;
        __syncthreads();
        if (tid < 64) {
            const LAS float* q0 = PL + ((tid >> 5) * 4) * 32 * 40 + (tid & 31) * 40;
            float lg[37];
#pragma unroll
            for (int q = 0; q < 37; ++q) lg[q] = (q0[q] + q0[32 * 40 + q]) + (q0[2 * 32 * 40 + q] + q0[3 * 32 * 40 + q]);
            const float rstd = rsqrtf(lg[36] * (1.f / D) + EPS);
            float gmax = lg[0] * rstd + p.b_rg[0]; int gi = 0;
#pragma unroll
            for (int q = 1; q < 4; ++q) { const float v = lg[q] * rstd + p.b_rg[q]; if (v > gmax) { gmax = v; gi = q; } }
            float gs = 0.f;
#pragma unroll
            for (int q = 0; q < 4; ++q) gs += __expf(lg[q] * rstd + p.b_rg[q] - gmax);
            const float gtop = 1.f / gs;
            float m1 = -INFINITY, m2 = -INFINITY; int i1 = 0, i2 = 0;
#pragma unroll
            for (int e = 0; e < 32; ++e) { const float v = lg[4 + e] * rstd + p.b_re[e];
                if ((e >> 3) == gi) { if (v > m1) { m2 = m1; i2 = i1; m1 = v; i1 = e; } else if (v > m2) { m2 = v; i2 = e; } } }
            const float e2 = __expf(m2 - m1);
            const float w1 = gtop / (1.f + e2), w2 = gtop * e2 / (1.f + e2);
            if (!dry) {
            const unsigned r1 = atomicAdd((unsigned*)&HC[i1], 1u), r2 = atomicAdd((unsigned*)&HC[i2], 1u);
            asm volatile("s_waitcnt lgkmcnt(0)" ::: "memory");
            if (tid < 32) { const unsigned c = HC[tid]; HC[32 + tid] = c ? atomicAdd(&gcount[tid], c) : 0u; }
            asm volatile("s_waitcnt vmcnt(0) lgkmcnt(0)" ::: "memory");
            const unsigned s1 = HC[32 + i1] + r1, s2 = HC[32 + i2] + r2; const int tok = tg * 64 + tid;
            LISTI[(size_t)i1 * T + s1] = tok * 2;     LISTR[(size_t)i1 * T + s1] = rstd; LISTW[(size_t)i1 * T + s1] = w1;
            LISTI[(size_t)i2 * T + s2] = tok * 2 + 1; LISTR[(size_t)i2 * T + s2] = rstd; LISTW[(size_t)i2 * T + s2] = w2;
            } else if (w1 + w2 == 12345.f) LISTW[0] = w1;
        }
        __syncthreads();
    }
}
template <int NPN> __device__ __forceinline__ bool moe_find(const LAS unsigned* ecnt, int L, pg8::Unit& u) {
    int e = 0, tp = 0, cnt = 0, found = 0;
    for (int q = 0; q < NE; ++q) { const int c = (int)ecnt[q], n = ((c + 255) >> 8) * NPN; if (!found) { if (L < n) { found = 1; e = q; cnt = c; } else { L -= n; tp += (c + 255) >> 8; } } }
    if (!__builtin_amdgcn_readfirstlane(found)) return false;
    u.aux = __builtin_amdgcn_readfirstlane(e); u.aux2 = __builtin_amdgcn_readfirstlane(tp) * 256; u.aux3 = __builtin_amdgcn_readfirstlane(cnt);
    const int Lr = __builtin_amdgcn_readfirstlane(L); u.pm = Lr / NPN; u.pn = Lr % NPN; return true;
}
constexpr int CW_M9 = 16512;
struct MoeOrder1 {
    static constexpr bool GATHER = true;
    int G, c; const LAS unsigned* ecnt; const char* X1B; const char* W; const int* LISTI; unsigned* ctl; bool count;
    __device__ bool next(int i, pg8::Unit& u) const {
        if (!moe_find<2>(ecnt, i * G + c, u)) return false;
        u.A = X1B; u.B = W + ((size_t)u.aux * 512 + 256 * u.pn) * D; u.nt = D / 128; u.unit_i = i; return true; }
    __device__ __forceinline__ void a_offsets(const pg8::Unit& u, const int (&Ra)[2], const int (&Ca)[2], unsigned (&voff)[2][2]) const {
#pragma unroll
        for (int hh = 0; hh < 2; ++hh)
#pragma unroll
            for (int i = 0; i < 2; ++i) { int idx = u.pm * 256 + hh * 128 + Ra[i]; idx = idx < u.aux3 ? idx : 0;
                voff[hh][i] = (unsigned)(LISTI[(size_t)u.aux * T + idx] >> 1) * (unsigned)D + (unsigned)Ca[i]; }
    }
    __device__ __forceinline__ void a_ready(const pg8::Unit&) const {}
    __device__ __forceinline__ void done(const pg8::Unit& u) const {
        asm volatile("s_waitcnt vmcnt(0)" ::: "memory");
        if (count && (threadIdx.x & 63) == 0) __hip_atomic_fetch_add(ctl + CW_M9 + 64 * u.unit_i, 1u, __ATOMIC_RELAXED, __HIP_MEMORY_SCOPE_AGENT);
    }
};
struct EpiMoe1 {
    static constexpr bool PERM = true; static constexpr bool KEEP = false;
    const float* LISTR; const float* LISTW; bf16* ACT;
    __device__ __forceinline__ void operator()(const f32x4 (&acc)[2][2][4][2], const pg8::Unit& u, int wr, int wc, int fr, int fq) const {
        const int e = u.aux, cnt = u.aux3;
        float rsv[2][4], wv[2][4];
#pragma unroll
        for (int ai = 0; ai < 2; ++ai)
#pragma unroll
            for (int m = 0; m < 4; ++m) { const int idx = u.pm * 256 + ai * 128 + wr * 64 + m * 16 + fr; const bool valid = idx < cnt;
                rsv[ai][m] = valid ? LISTR[(size_t)e * T + idx] : 0.f; wv[ai][m] = valid ? LISTW[(size_t)e * T + idx] : 0.f; }
#pragma unroll
        for (int ai = 0; ai < 2; ++ai)
#pragma unroll
            for (int m = 0; m < 4; ++m) { const int idx = u.pm * 256 + ai * 128 + wr * 64 + m * 16 + fr; const bool valid = idx < cnt;
                const float rs = rsv[ai][m] * (1.f / 64.f), w = wv[ai][m];
                f32x4 a0, a1;
#pragma unroll
                for (int q = 0; q < 4; ++q) { const float g0 = acc[ai][0][m][0][q] * rs, g1 = acc[ai][0][m][1][q] * rs;
                    a0[q] = g0 * fsig(g0) * (acc[ai][1][m][0][q] * rs) * w; a1[q] = g1 * fsig(g1) * (acc[ai][1][m][1][q] * rs) * w; }
                u32x4 o; o.x = cvt_pk_bf16(a0[0], a0[1]); o.y = cvt_pk_bf16(a0[2], a0[3]); o.z = cvt_pk_bf16(a1[0], a1[1]); o.w = cvt_pk_bf16(a1[2], a1[3]);
                if (valid) { bf16* dp = ACT + (size_t)(u.aux2 + idx) * EFF + u.pn * 128 + wc * 32 + 8 * fq;
                    asm volatile("global_store_dwordx4 %0, %1, off sc1\n\ts_nop 1" :: "v"(dp), "v"(o) : "memory"); } }
    }
};
struct MoeOrder2 {
    static constexpr bool GATHER = false;
    const LAS unsigned* ecnt; const char* ACT; const char* W; int u0, ustep, ulim, imax;
    __device__ bool next(int i, pg8::Unit& u) const {
        const int L = u0 + i * ustep;
        if (i >= imax || L >= ulim || !moe_find<8>(ecnt, L, u)) return false;
        u.A = ACT + (size_t)(u.aux2 + 256 * u.pm) * EFF * 2; u.B = W + ((size_t)u.aux * D + 256 * u.pn) * EFF * 2; u.nt = EFF / 64; u.unit_i = i; return true; }
    __device__ __forceinline__ void a_offsets(const pg8::Unit&, const int (&)[2], const int (&)[2], unsigned (&)[2][2]) const {}
    __device__ __forceinline__ void a_ready(const pg8::Unit&) const {}
    __device__ __forceinline__ void done(const pg8::Unit&) const {}
};
__device__ __forceinline__ void moe_wait_round(unsigned* ctl, int r, int want) {
    if (threadIdx.x < 64) { unsigned sp = 0;
        while ((int)__builtin_amdgcn_readfirstlane(__hip_atomic_load(ctl + CW_M9 + 64 * r, __ATOMIC_RELAXED, __HIP_MEMORY_SCOPE_AGENT)) < want) { __builtin_amdgcn_s_sleep(2); if (++sp > (1u << 22)) break; }
        __builtin_amdgcn_fence(__ATOMIC_ACQUIRE, "agent");
        asm volatile("s_waitcnt vmcnt(0)" ::: "memory");
    }
    __syncthreads();
}
struct EpiMoe2 {
    static constexpr bool PERM = true; static constexpr bool KEEP = false;
    const int* LISTI; bf16* YS;
    __device__ __forceinline__ void operator()(const f32x4 (&acc)[2][2][4][2], const pg8::Unit& u, int wr, int wc, int fr, int fq) const {
        const int e = u.aux, cnt = u.aux3;
        int ent[2][4];
#pragma unroll
        for (int ai = 0; ai < 2; ++ai)
#pragma unroll
            for (int m = 0; m < 4; ++m) { const int idx = u.pm * 256 + ai * 128 + wr * 64 + m * 16 + fr; ent[ai][m] = (idx < cnt) ? LISTI[(size_t)e * T + idx] : -1; }
#pragma unroll
        for (int ai = 0; ai < 2; ++ai)
#pragma unroll
            for (int m = 0; m < 4; ++m) {
#pragma unroll
                for (int bj = 0; bj < 2; ++bj) { const f32x4 v0 = acc[ai][bj][m][0] * 64.f, v1 = acc[ai][bj][m][1] * 64.f;
                    u32x2 o; { unsigned w_ = 0; w_ = F8PK(v0[0], v0[1], w_, false); w_ = F8PK(v0[2], v0[3], w_, true); o.x = w_; }
                    { unsigned w_ = 0; w_ = F8PK(v1[0], v1[1], w_, false); w_ = F8PK(v1[2], v1[3], w_, true); o.y = w_; }
                    if (ent[ai][m] >= 0) *(u32x2*)((unsigned char*)YS + (size_t)ent[ai][m] * D + u.pn * 256 + bj * 128 + wc * 32 + 8 * fq) = o; } }
    }
};

__global__ void __launch_bounds__(NWAVES * 64, 2) mk_fwd(Args args) {
    extern __shared__ __attribute__((aligned(16))) unsigned char lds_raw[];
    LAS unsigned char* lds = (LAS unsigned char*)lds_raw;
    volatile LAS unsigned* MISC = (volatile LAS unsigned*)(lds + MISC_OFF);
    const P& p = args.p;
    const int tid = threadIdx.x, lane = tid & 63, wave = __builtin_amdgcn_readfirstlane(tid >> 6);
    const int G = gridDim.x; const int bx = blockIdx.x; const int vcu = (G % 8 == 0) ? (bx % 8) * (G / 8) + bx / 8 : bx;
    unsigned char* ws = p.ws;
    unsigned* ctl = (unsigned*)(ws + WS_CTL);
    for (int u = tid; u < (LDS_BYTES - LDSCTL_OFF) / 4; u += NWAVES * 64) ((LAS unsigned*)(lds + LDSCTL_OFF))[u] = 0u;
    __syncthreads();
    XcdBarrier bar = xcd_barrier_post(ctl + CW_BAR + args.li * XCD_BAR_WORDS, MISC + 8);
    const int lo = args.ph_lo, hi = args.ph_hi;
#define IN(k) (lo <= (k) && (k) < hi)
#define BOTH(k) (IN(k) && IN((k) + 1))
#define GRID_BAR() xcd_barrier(bar)
    const int gw = vcu * NWAVES + wave, NGW = G * NWAVES;

    if (IN(0)) {
        LAS float* scr = (LAS float*)(lds + RING_OFF + wave * 16384);
        bf16* XB = (bf16*)(ws + WS_XB); unsigned* XF8 = (unsigned*)(ws + WS_XF8); float* rstd1 = (float*)(ws + WS_RSTD1);
        {
            f32x4 va[8], vb[8];
            int m = gw;
            if (m < T && !(args.pad & 8)) { x_ldrow(p.x, m, lane, va);
                for (;;) { const bool hb = m + NGW < T; if (hb) x_ldrow(p.x, m + NGW, lane, vb); x_strow(XB, XF8, rstd1, m, lane, va); if (!hb) break; m += NGW;
                           const bool ha = m + NGW < T; if (ha) x_ldrow(p.x, m + NGW, lane, va); x_strow(XB, XF8, rstd1, m, lane, vb); if (!ha) break; m += NGW; } }
        }
        t_run<0>(p, gw, NGW, lane, scr); t_run<8>(p, gw, NGW, lane, scr);
        t_run<1>(p, gw, NGW, lane, scr); t_run<2>(p, gw, NGW, lane, scr); t_run<3>(p, gw, NGW, lane, scr); t_run<4>(p, gw, NGW, lane, scr);
        if (!(args.pad & 4)) { t_run<7>(p, gw, NGW, lane, scr); t_run<5>(p, gw, NGW, lane, scr, 0, 8192); t_run<6>(p, gw, NGW, lane, scr, 0, 2048); }
        {
            bf16* WRH = (bf16*)(ws + WS_WRH); bf16* WRL = (bf16*)(ws + WS_WRL); bf16* WGH = (bf16*)(ws + WS_WGH); bf16* WGL = (bf16*)(ws + WS_WGL);
            for (int e = gw * 64 + lane; e < D * 32; e += NGW * 64) { const int kb = e >> 8, col = (e >> 3) & 31, k = kb * 8 + (e & 7);
                const float nw = p.norm_ffn_w[k]; const float w = nw * p.w_re[k * 32 + col]; const bf16 wh = f2bf(w); WRH[e] = wh; WRL[e] = f2bf(w - bf2f(wh));
                const float g = nw * p.w_rg[k * 4 + (col & 3)] * ((col < 4) ? 1.f : 0.f); const bf16 gh = f2bf(g); WGH[e] = gh; WGL[e] = f2bf(g - bf2f(gh)); }
        }
        __syncthreads();
        for (int it = vcu; it < S5G * 8; it += G) p0_s5_kt(p, lds + RING_OFF, it >> 3, it & 7, tid);
        if (BOTH(0)) GRID_BAR();
    }
    if (IN(1)) {
        EpiInproj E{(const float*)(ws + WS_RSTD1), p.b_gate, (bf16*)(ws + WS_U5X), (bf16*)(ws + WS_XL), (bf16*)(ws + WS_GY), (bf16*)(ws + WS_GATES)};
        {   pg8::PlainOrder S; S.init(T, 3584, D, D, D, ws + WS_XB, ws + WS_WINT, G, bx);
            pg8::gemm_phase<EpiInproj, pg8::PlainOrder, true>(lds + RING_OFF, S, E, D, D); }
        {
            constexpr int NB = (T / 256) * (3584 / 256), NF = (T / 256) * (4096 / 256);
            const int r = NB % G, nl = G - r;
            Fp8Order S; S.po.init(T, 4096, D / 2, D / 2, D / 2, ws + WS_XF8, ws + WS_WG8, G, bx);
            if (r == 0) { S.w0 = bx; S.wstep = G; S.wn = 1 << 20; }
            else { int a = (NF - 2 * nl) / G; if (a < 0) a = 0; const int NL = nl * (a + 2);
                if (bx >= r) { S.w0 = bx - r; S.wstep = nl; S.wn = a + 2; } else { S.w0 = NL + bx; S.wstep = r; S.wn = 1 << 20; } }
            pg8::gemm_phase<EpiInproj, Fp8Order, true, true>(lds + RING_OFF, S, E, D / 2, D / 2); }
        for (int it = bx; it < S5G * 8; it += G) p0_s5_build(p, lds + RING_OFF, it >> 3, it & 7, tid);
        if (BOTH(1)) GRID_BAR();
    }
    if (IN(2)) {
        const int lane = lane_now();
        if (bx < S5G) { if (!(args.pad & 512)) {
            const int g = bx;
            {   S5EOrder S{1, 2 * g, 2 * g + 2, (const char*)(ws + WS_U5X), (const char*)(ws + WS_BTE)}; EpiS5E E{(float*)(ws + WS_SEND)};
                pg8::gemm_phase<EpiS5E, S5EOrder, true>(lds + RING_OFF, S, E, S5KT, S5KU); }
            asm volatile("s_waitcnt vmcnt(0)" ::: "memory"); __syncthreads();
            if (wave == 0) { __builtin_amdgcn_fence(__ATOMIC_ACQUIRE, "agent"); scan_s5(p, g, lane); asm volatile("s_waitcnt vmcnt(0)" ::: "memory"); __builtin_amdgcn_fence(__ATOMIC_ACQUIRE, "agent"); }
            __syncthreads();
            {   S5COrder S{1, 4 * g, 4 * g + 4, (const char*)(ws + WS_U5X), (const char*)(ws + WS_BTY)}; EpiS5C E{(const bf16*)(ws + WS_U5X), p.s5_d, (bf16*)(ws + WS_Y5)};
                pg8::gemm_phase<EpiS5C, S5COrder, true>(lds + RING_OFF, S, E, S5KT, S5KT); }
        } } else if (!(args.pad & 1024)) {
            lru_pass<0, true>(p, lds + RING_OFF, G - S5G, bx - S5G, tid, lane, wave, 0, 0);
            lru_mid(p, lds, ctl, args.li, G - S5G, bx - S5G, tid);
            lru_pass<1, true>(p, lds + RING_OFF, G - S5G, bx - S5G, tid, lane, wave, 0, 0);
        }
        if (IN(2) && IN(5)) GRID_BAR();
    }
    if (IN(5)) {
        const int lane = lane_now();
        pg8::PlainOrder S; S.init(T, S5W, S5W, S5W, S5W, ws + WS_Y5, ws + WS_WGLUT, G, bx);
        EpiGlu E{(const bf16*)(ws + WS_Y5), p.s5_b_glu, (bf16*)(ws + WS_OUTC)};
        pg8::gemm_phase<EpiGlu, pg8::PlainOrder, true>(lds + RING_OFF, S, E, S5W, S5W);
        {   const int nun = (T / 256) * (S5W / 256);
            if (bx >= nun && G > nun) { LAS float* scr = (LAS float*)(lds + RING_OFF + wave * 16384); t_run<6>(p, (bx - nun) * NWAVES + wave, (G - nun) * NWAVES, lane, scr, 2048, 8192); }
            else if (G <= nun) { LAS float* scr = (LAS float*)(lds + RING_OFF + wave * 16384); t_run<6>(p, gw, NGW, lane, scr, 2048, 8192); } }
        if (BOTH(5)) GRID_BAR();
    }
    if (IN(6)) {
        ProjOrder S; S.po.init(T, D, D / 2, D / 2, D / 2, ws + WS_OUTC, ws + WS_WPT, G, bx);
        EpiProj E{(const bf16*)(ws + WS_GATES), (bf16*)(ws + WS_MERGED)};
        pg8::gemm_phase<EpiProj, ProjOrder, true, true>(lds + RING_OFF, S, E, D / 2, D / 2);
        if (BOTH(6)) GRID_BAR();
    }
    if (IN(7)) {
        pg8::PlainOrder S; S.init(T, D, D / 2, D / 2, D / 2, ws + WS_MERGED, ws + WS_WOUTT, G, bx);
        EpiWout E{(bf16*)(ws + WS_DELTA), (const bf16*)(ws + WS_XB)};
        pg8::gemm_phase<EpiWout, pg8::PlainOrder, true, true>(lds + RING_OFF, S, E, D / 2, D / 2);
        if (BOTH(7)) GRID_BAR();
    }
    if (IN(8)) {
        const int lane = lane_now();
        router_phase(p, lds + RING_OFF, G, bx, tid, lane, wave, (args.pad & 1) != 0);
        if (BOTH(8)) GRID_BAR();
    }
    LAS unsigned* ecnt = (LAS unsigned*)(lds + ECNT_OFF);
    if (IN(9)) { if (tid < NE) ecnt[tid] = __hip_atomic_load(ctl + CW_ECNT + tid, __ATOMIC_RELAXED, __HIP_MEMORY_SCOPE_AGENT); __syncthreads(); }
    if (IN(9)) {
        int U9 = 0;
        for (int q = 0; q < NE; ++q) U9 += (((int)ecnt[q] + 255) >> 8) * 2;
        U9 = __builtin_amdgcn_readfirstlane(U9);
        for (int rep = (args.pad & 128) ? 0 : 1; rep < 2; ++rep) {
            MoeOrder1 S{G, vcu, ecnt, (const char*)(ws + WS_X1B), (const char*)(ws + WS_WGUT), (const int*)(ws + WS_LISTI), ctl, rep == 1};
            EpiMoe1 E{(const float*)(ws + WS_LISTR), (const float*)(ws + WS_LISTW), (bf16*)(ws + WS_ACT)};
            pg8::gemm_phase<EpiMoe1, MoeOrder1, true, true>(lds + RING_OFF, S, E, D / 2, D / 2); }
        const int U10 = U9 * 4;
        const char* ACTp = (const char*)(ws + WS_ACT); const char* WDp = (const char*)(ws + WS_WDT);
        EpiMoe2 E2{(const int*)(ws + WS_LISTI), (bf16*)(ws + WS_YS8)};
        for (int rep2 = (args.pad & 64) ? 0 : 1; rep2 < 2; ++rep2)
        if (U9 > G && U9 <= 2 * G) {
            const int R2 = U9 - G, GL = G - R2, N0 = 4 * G, N1 = U10 - N0, nh = (3 * R2 < N1) ? 3 * R2 : N1;
            if (vcu >= R2) { moe_wait_round(ctl, 0, G * 8);
                MoeOrder2 S{ecnt, ACTp, WDp, vcu - R2, GL, N0, 1 << 20}; pg8::gemm_phase<EpiMoe2, MoeOrder2, true>(lds + RING_OFF, S, E2, EFF, EFF); }
            moe_wait_round(ctl, 1, R2 * 8);
            if (vcu < R2) { MoeOrder2 S{ecnt, ACTp, WDp, N0 + vcu, R2, N0 + nh, 3}; pg8::gemm_phase<EpiMoe2, MoeOrder2, true>(lds + RING_OFF, S, E2, EFF, EFF); }
            else { MoeOrder2 S{ecnt, ACTp, WDp, N0 + nh + (G - 1 - vcu), GL, U10, 1 << 20}; pg8::gemm_phase<EpiMoe2, MoeOrder2, true>(lds + RING_OFF, S, E2, EFF, EFF); }
        } else
        for (int r = 0; r * G < U9; ++r) {
            int want = U9 - r * G; want = (want > G ? G : want) * 8;
            moe_wait_round(ctl, r, want);
            MoeOrder2 S{ecnt, ACTp, WDp, 4 * r * G + vcu, G, U10, 4};
            pg8::gemm_phase<EpiMoe2, MoeOrder2, true>(lds + RING_OFF, S, E2, EFF, EFF); }
        GRID_BAR();
    }
    if (IN(11)) {
        const int lane = lane_now();
        const unsigned char* YS = (const unsigned char*)(ws + WS_YS8); const bf16* DL = (const bf16*)(ws + WS_DELTA);
#define FIN_LOAD(m_, A, B, C) do { const GAS unsigned* y0_ = (const GAS unsigned*)(YS + (size_t)(2 * (m_)) * D) + lane; \
            const GAS unsigned* y1_ = (const GAS unsigned*)(YS + (size_t)(2 * (m_) + 1) * D) + lane; const GAS u32x2* dd_ = (const GAS u32x2*)(DL + (size_t)(m_) * D) + lane; \
            _Pragma("unroll") for (int j = 0; j < 8; ++j) { A[j] = y0_[64 * j]; B[j] = y1_[64 * j]; C[j] = dd_[64 * j]; } } while (0)
#define FIN_STORE(m_, A, B, C) do { float ss_ = 0.f; f32x4 X[8]; \
            _Pragma("unroll") for (int j = 0; j < 8; ++j) { const f32x2 a01 = __builtin_amdgcn_cvt_pk_f32_fp8(A[j], false), a23 = __builtin_amdgcn_cvt_pk_f32_fp8(A[j], true), b01 = __builtin_amdgcn_cvt_pk_f32_fp8(B[j], false), b23 = __builtin_amdgcn_cvt_pk_f32_fp8(B[j], true); \
                X[j].x = (a01.x + b01.x) * (1.f / 64.f) + __uint_as_float(C[j].x << 16); X[j].y = (a01.y + b01.y) * (1.f / 64.f) + __uint_as_float(C[j].x & 0xffff0000u); \
                X[j].z = (a23.x + b23.x) * (1.f / 64.f) + __uint_as_float(C[j].y << 16); X[j].w = (a23.y + b23.y) * (1.f / 64.f) + __uint_as_float(C[j].y & 0xffff0000u); \
                ss_ += (X[j].x * X[j].x + X[j].y * X[j].y) + (X[j].z * X[j].z + X[j].w * X[j].w); } \
            const float rs_ = rsqrtf(wave_sum(ss_) * (1.f / D) + EPS); GAS f32x4* xo_ = (GAS f32x4*)(p.out + (size_t)(m_) * D) + lane; \
            _Pragma("unroll") for (int j = 0; j < 8; ++j) { const f32x4 nw = *((const f32x4*)p.norm_final_w + lane + 64 * j); xo_[64 * j] = X[j] * rs_ * nw; } } while (0)
        {   unsigned ya0[8], ya1[8], yb0[8], yb1[8]; u32x2 da[8], db[8];
            int m = gw;
            if (m < T) { FIN_LOAD(m, ya0, ya1, da);
                for (;;) { const bool hb = m + NGW < T; if (hb) FIN_LOAD(m + NGW, yb0, yb1, db); FIN_STORE(m, ya0, ya1, da); if (!hb) break; m += NGW;
                           const bool ha = m + NGW < T; if (ha) FIN_LOAD(m + NGW, ya0, ya1, da); FIN_STORE(m, yb0, yb1, db); if (!ha) break; m += NGW; } } }
#undef FIN_LOAD
#undef FIN_STORE
    }
    if (args.pad & 256) { for (int q = 0; q < 8; ++q) GRID_BAR(); }
#undef IN
#undef BOTH
#undef GRID_BAR
}

extern "C" void kernel_launch(void* const* d_in, const int* in_sizes, int n_in, void* d_out, int out_size, void* d_ws, size_t ws_size, hipStream_t stream) {
    static int grid = 0;
    if (grid == 0) {
        if (n_in != 33 || ws_size < WS_END) { fprintf(stderr, "kernel_launch: bad n_in %d or ws_size %zu < %zu\n", n_in, ws_size, (size_t)WS_END); grid = -1; return; }
        int dev = 0, cus = 0, per_cu = 0;
        if (hipGetDevice(&dev) != hipSuccess || hipDeviceGetAttribute(&cus, hipDeviceAttributeMultiprocessorCount, dev) != hipSuccess) { grid = -1; return; }
        if (hipFuncSetAttribute((const void*)mk_fwd, hipFuncAttributeMaxDynamicSharedMemorySize, LDS_BYTES) != hipSuccess) { fprintf(stderr, "kernel_launch: hipFuncSetAttribute failed\n"); grid = -1; return; }
        if (hipOccupancyMaxActiveBlocksPerMultiprocessor(&per_cu, (const void*)mk_fwd, NWAVES * 64, LDS_BYTES) != hipSuccess || per_cu < 1) { fprintf(stderr, "kernel_launch: occupancy query says %d blocks per CU\n", per_cu); grid = -1; return; }
        (void)hipGetLastError();
        if (cus < 248) { fprintf(stderr, "kernel_launch: %d CUs: the fused mixer phase needs at least 248 workgroups\n", cus); grid = -1; return; }
        grid = cus;
    }
    if (grid < 0) return;
    Args a{};
    const float** f = (const float**)&a.p;
    for (int i = 0; i < 33; ++i) f[i] = (const float*)d_in[i];
    a.p.out = (float*)d_out; a.p.ws = (unsigned char*)d_ws;
    const P& p = a.p; unsigned char* ws = p.ws;
    (void)hipMemsetAsync(ws + WS_CTL, 0, CTL_ZERO_BYTES, stream);
#if defined(PROBE_LO)
    a.ph_lo = 0; a.ph_hi = PROBE_HI; a.li = 0;
#if defined(PROBE_DRY)
    a.pad = PROBE_DRY;
#endif
    hipLaunchKernelGGL(mk_fwd, dim3(grid), dim3(NWAVES * 64), LDS_BYTES, stream, a);
    a.ph_lo = PROBE_LO; a.ph_hi = 12; a.li = 1; a.pad = 0;
    hipLaunchKernelGGL(mk_fwd, dim3(grid), dim3(NWAVES * 64), LDS_BYTES, stream, a);
#else
    a.ph_lo = 0; a.ph_hi = 12; a.li = 0;
#if defined(PROBE_SINGLE)
    a.pad = PROBE_SINGLE;
#endif
    hipLaunchKernelGGL(mk_fwd, dim3(grid), dim3(NWAVES * 64), LDS_BYTES, stream, a);
#endif
}
```

```cpp
#include <hip/hip_runtime.h>
#include <stdint.h>
#include <stdio.h>

constexpr int T = 16384, D = 2048;
constexpr int S5W = 512, S5G = 32, S5GS = 16, S5P = 64;
constexpr int LW = 1536, LH = 12, LHD = 128;
constexpr int INC = 7680;
constexpr int NE = 32, EFF = 256;
constexpr float EPS = 1e-6f;

typedef unsigned short bf16;
#define LAS __attribute__((address_space(3)))
#define GAS __attribute__((address_space(1)))
typedef short bf16x8 __attribute__((ext_vector_type(8)));
typedef float f32x4 __attribute__((ext_vector_type(4)));
typedef float f32x2 __attribute__((ext_vector_type(2)));
typedef float f32x16 __attribute__((ext_vector_type(16)));
typedef unsigned u32x4 __attribute__((ext_vector_type(4)));
typedef unsigned u32x2 __attribute__((ext_vector_type(2)));
typedef int i32x8 __attribute__((ext_vector_type(8)));
typedef int i32x4 __attribute__((ext_vector_type(4)));

__device__ __forceinline__ float bf2f(bf16 v) { return __uint_as_float(((unsigned)v) << 16); }
__device__ __forceinline__ bf16 f2bf(float f) { unsigned u = __float_as_uint(f); return (bf16)((u + 0x7fffu + ((u >> 16) & 1u)) >> 16); }
__device__ __forceinline__ unsigned pk2(float lo, float hi) { return (unsigned)f2bf(lo) | ((unsigned)f2bf(hi) << 16); }
__device__ __forceinline__ unsigned cvt_pk_bf16(float lo, float hi) { unsigned r; asm volatile("v_cvt_pk_bf16_f32 %0, %1, %2" : "=v"(r) : "v"(lo), "v"(hi)); return r; }
__device__ __forceinline__ float sigmoidf_(float v) { return 1.f / (1.f + __expf(-v)); }
__device__ __forceinline__ float gelu_tanh(float v) { const float u = 0.7978845608028654f * (v + 0.044715f * v * v * v); return 0.5f * v * (1.f + tanhf(u)); }
#define F8PK(a, b, old, hi) __builtin_amdgcn_cvt_pk_fp8_f32(__builtin_amdgcn_fmed3f((a), -448.f, 448.f), __builtin_amdgcn_fmed3f((b), -448.f, 448.f), (old), (hi))
__device__ __forceinline__ float fsig(float v) { return __builtin_amdgcn_rcpf(1.f + __builtin_amdgcn_exp2f(-1.4426950408889634f * v)); }
__device__ __forceinline__ float fgelu(float v) { const float u2 = 1.5957691216057308f * (v + 0.044715f * v * v * v); return v * fsig(u2); }

constexpr int LC = 32, NCH = T / LC;
constexpr int S5KU = LC * 16, S5KT = S5KU + 128;
constexpr int LTT = 64, LNT = T / LTT;
constexpr size_t MiB = 1u << 20;
constexpr size_t WS_CTL   = 0, CTL_ZERO_BYTES = 1 * MiB;
constexpr size_t WS_RSTD1 = 1 * MiB;
constexpr size_t WS_LAML  = 1 * MiB + 128 * 1024;
constexpr size_t WS_ROUTE = 1 * MiB + 256 * 1024;
constexpr size_t WS_WG    = 1 * MiB + 192 * 1024;
constexpr size_t WS_WR    = 1 * MiB + 768 * 1024;
constexpr size_t WS_WGLUT = 2 * MiB;
constexpr size_t WS_WLT   = 3 * MiB;
constexpr size_t WS_KTG   = 7 * MiB;
constexpr size_t WS_WG8   = 9 * MiB;
constexpr size_t WS_KTG_OLD = 8 * MiB + 512 * 1024;
constexpr size_t WS_AG    = 4 * MiB;
constexpr size_t WS_HIN   = 7 * MiB;
constexpr size_t WS_SEND  = 9 * MiB;
constexpr size_t WS_LISTI = 9 * MiB;
constexpr size_t WS_LISTR = 11 * MiB;
constexpr size_t WS_LISTW = 13 * MiB;
constexpr size_t WS_BTE   = 17 * MiB;
constexpr size_t WS_BTY   = 21 * MiB;
constexpr size_t WS_WPT   = 41 * MiB;
constexpr size_t WS_WOUTT = 49 * MiB;
constexpr size_t WS_WGUT  = 57 * MiB;
constexpr size_t WS_WDT   = 121 * MiB;
constexpr size_t WS_U5X   = 153 * MiB;
constexpr size_t WS_XL    = 173 * MiB;
constexpr size_t WS_GY    = 221 * MiB;
constexpr size_t WS_GATES = 269 * MiB;
constexpr size_t WS_XB    = 397 * MiB;
constexpr size_t WS_WINT  = 461 * MiB;
constexpr size_t WS_XF8   = 475 * MiB;
constexpr size_t WS_Y5    = 461 * MiB;
constexpr size_t WS_OUTC  = 477 * MiB;
constexpr size_t WS_X1B   = 173 * MiB;
constexpr size_t WS_OUTL  = 57 * MiB;
constexpr size_t WS_MERGED= 153 * MiB;
constexpr size_t WS_ACT   = 461 * MiB;
constexpr size_t WS_YS8   = 333 * MiB;
constexpr size_t WS_DELTA = 269 * MiB;
constexpr size_t WS_END   = 509 * MiB;

struct P {
    const float *x, *norm_mix_w, *w_in, *b_gate, *s5_lam_re, *s5_lam_im, *s5_log_step, *s5_b_re, *s5_b_im, *s5_c_re, *s5_c_im, *s5_d, *s5_w_glu, *s5_b_glu;
    const float *lru_conv_w, *lru_conv_b, *lru_w_a, *lru_b_a, *lru_w_x, *lru_b_x, *lru_lambda, *w_proj_s5, *w_proj_lru, *w_out, *norm_ffn_w;
    const float *w_rg, *b_rg, *w_re, *b_re, *w_e_gate, *w_e_up, *w_e_down, *norm_final_w;
    float* out; unsigned char* ws;
};

namespace pg8 {
constexpr int BM = 256, BK = 64, HALF = 128, HTB = HALF * BK * 2  , STAGE_BYTES = 8 * HTB, NXCD = 8, WGM = 8;
__host__ __device__ __forceinline__ int lds_byte(int r, int c) { const int st = (r >> 4) * 2 + (c >> 5), rr = r & 15, cc = c & 31, ob = rr * 64 + cc * 2; return st * 1024 + (ob ^ (((ob >> 9) & 1) << 5)); }
__host__ __device__ __forceinline__ void stage_rc(int b, int& R, int& C) { const int st = b / 1024, sb = b % 1024, swz = sb ^ (((sb >> 9) & 1) << 5); R = (st >> 1) * 16 + swz / 64; C = (st & 1) * 32 + (swz % 64) / 2; }
__host__ __device__ __forceinline__ int perm32(int rho) { const int n = rho >> 4, i = rho & 15; return 8 * (i >> 2) + 4 * n + (i & 3); }

struct Unit { int pm, pn; const char* A; const char* B; int nt; int aux, aux2, aux3, unit_i; };

struct PlainOrder {
    static constexpr bool GATHER = false;
    int nM, nN, nwg, G, c, nt; const char* A; const char* B; size_t astep, bstep;
    __device__ void init(int M, int N, int K, int lda, int ldb, const void* A_, const void* B_, int G_, int c_) {
        nM = M / BM; nN = N / BM; nwg = nM * nN; G = G_; c = c_; nt = K / BK; A = (const char*)A_; B = (const char*)B_; astep = (size_t)BM * lda * 2; bstep = (size_t)BM * ldb * 2; }
    __device__ bool next(int i, Unit& u) const { return next_L((long)i * G + c, u); }
    __device__ bool next_L(long L, Unit& u) const {
        if (L >= nwg) return false;
        int wgid = (int)L; { const int q = nwg / NXCD, r = nwg % NXCD, xcd = wgid % NXCD, off = wgid / NXCD; wgid = (xcd < r ? xcd * (q + 1) : r * (q + 1) + (xcd - r) * q) + off; }
        const int nig = WGM * nN, gid = wgid / nig, fm = gid * WGM, gsz = (nM - fm) < WGM ? (nM - fm) : WGM;
        u.pm = fm + ((wgid % nig) % gsz); u.pn = (wgid % nig) / gsz; u.A = A + (size_t)u.pm * astep; u.B = B + (size_t)u.pn * bstep; u.nt = nt; u.aux = 0; return true;
    }
    __device__ __forceinline__ void a_offsets(const Unit&, const int (&)[2], const int (&)[2], unsigned (&)[2][2]) const {}
    __device__ __forceinline__ void a_ready(const Unit&) const {}
    __device__ __forceinline__ void done(const Unit&) const {}
};

template <class Epi, class Sched, bool ALIGN_EPI, bool FP8 = false>
__device__ __forceinline__ void gemm_phase(LAS unsigned char* lds, const Sched& S, const Epi& E, int lda, int ldb) {
    const int tid = threadIdx.x, wid = __builtin_amdgcn_readfirstlane(tid >> 6), lane = tid & 63, wr = wid >> 2, wc = wid & 3, fr = lane & 15, fq = lane >> 4;
    unsigned voffAc[2][2], voffAn[2][2], voffB[2]; int Ra[2], Ca[2];
#pragma unroll
    for (int i = 0; i < 2; ++i) { int R, C; stage_rc(tid * 16 + i * 8192, R, C); const int Rb = Epi::PERM ? ((R & ~31) + perm32(R & 31)) : R;
        Ra[i] = R; Ca[i] = C * 2;
        voffAc[0][i] = (unsigned)(R * lda + C) * 2u; voffAc[1][i] = (unsigned)((R + HALF) * lda + C) * 2u; voffB[i] = (unsigned)(Rb * ldb + C) * 2u; }
    const size_t kstep = (size_t)(BK * 2);
    const size_t hstepB = (size_t)HALF * ldb * 2;
    const unsigned ldsw = (unsigned)wid * 1024u;
    const int aoff = lds_byte(wr * 64 + fr, fq * 8), boff = lds_byte(wc * 32 + fr, fq * 8);
#define PG8_SA(b, h) (((b) * 2 + (h)) * HTB)
#define PG8_SB(b, h) ((4 + (b) * 2 + (h)) * HTB)
#define PG8_STAGE2(bufoff, gbase, o0, o1) do { \
        __builtin_amdgcn_global_load_lds((const unsigned*)((const char*)(gbase) + (o0)), (LAS unsigned*)(lds + (bufoff) + ldsw), 16, 0, 0); \
        __builtin_amdgcn_global_load_lds((const unsigned*)((const char*)(gbase) + (o1)), (LAS unsigned*)(lds + (bufoff) + ldsw + 8192), 16, 0, 0); } while (0)
#define PG8_STAGE_B(bufoff, gbase) PG8_STAGE2(bufoff, gbase, voffB[0], voffB[1])
#define PG8_STAGE_AC(bufoff, gbase, h) PG8_STAGE2(bufoff, gbase, voffAc[h][0], voffAc[h][1])
#define PG8_STAGE_AX(bufoff, gbase, h) PG8_STAGE2(bufoff, gbase, (Sched::GATHER && last) ? voffAn[h][0] : voffAc[h][0], (Sched::GATHER && last) ? voffAn[h][1] : voffAc[h][1])
#define PG8_LD16(off) (*(const LAS i32x4*)(lds + (off)))
#define PG8_LDA(dst, b, h) do { if constexpr (FP8) { _Pragma("unroll") for (int m = 0; m < 4; ++m) dst##8[m] = __builtin_shufflevector(PG8_LD16(PG8_SA(b, h) + aoff + m * 2048), PG8_LD16(PG8_SA(b, h) + aoff + m * 2048 + 1024), 0, 1, 2, 3, 4, 5, 6, 7); } \
        else { _Pragma("unroll") for (int m = 0; m < 4; ++m) _Pragma("unroll") for (int k = 0; k < 2; ++k) dst[m][k] = *(const LAS bf16x8*)(lds + PG8_SA(b, h) + aoff + m * 2048 + k * 1024); } } while (0)
#define PG8_LDB(dst, b, h) do { if constexpr (FP8) { _Pragma("unroll") for (int n = 0; n < 2; ++n) dst##8[n] = __builtin_shufflevector(PG8_LD16(PG8_SB(b, h) + boff + n * 2048), PG8_LD16(PG8_SB(b, h) + boff + n * 2048 + 1024), 0, 1, 2, 3, 4, 5, 6, 7); } \
        else { _Pragma("unroll") for (int n = 0; n < 2; ++n) _Pragma("unroll") for (int k = 0; k < 2; ++k) dst[n][k] = *(const LAS bf16x8*)(lds + PG8_SB(b, h) + boff + n * 2048 + k * 1024); } } while (0)
#define PG8_MMA(ai, bj, At, Bt) do { __builtin_amdgcn_s_setprio(1); \
        if constexpr (FP8) { _Pragma("unroll") for (int m = 0; m < 4; ++m) _Pragma("unroll") for (int n = 0; n < 2; ++n) \
            asm volatile("v_mfma_f32_16x16x128_f8f6f4 %0, %1, %2, %0" : "+v"(acc[ai][bj][m][n]) : "v"(Bt##8[n]), "v"(At##8[m])); } \
        else { _Pragma("unroll") for (int m = 0; m < 4; ++m) _Pragma("unroll") for (int n = 0; n < 2; ++n) _Pragma("unroll") for (int k = 0; k < 2; ++k) \
            acc[ai][bj][m][n] = __builtin_amdgcn_mfma_f32_16x16x32_bf16(Bt[n][k], At[m][k], acc[ai][bj][m][n], 0, 0, 0); } \
        __builtin_amdgcn_s_setprio(0); } while (0)
#define PG8_WAIT_V(n) asm volatile("s_waitcnt vmcnt(" #n ")" ::: "memory")
#define PG8_WAIT_L(n) asm volatile("s_waitcnt lgkmcnt(" #n ")" ::: "memory")
#define PG8_BAR __builtin_amdgcn_s_barrier()
#define PG8_SCHED __builtin_amdgcn_sched_barrier(0)
    Unit cur, nxt; int ui = 0;
    if (!S.next(0, cur)) return;
    if constexpr (Sched::GATHER) S.a_offsets(cur, Ra, Ca, voffAc);
    f32x4 acc[2][2][4][2];
#pragma unroll
    for (int a = 0; a < 2; ++a)
#pragma unroll
        for (int b = 0; b < 2; ++b)
#pragma unroll
            for (int m = 0; m < 4; ++m)
#pragma unroll
                for (int n = 0; n < 2; ++n) acc[a][b][m][n] = (f32x4){0.f, 0.f, 0.f, 0.f};
    if constexpr (FP8) {
#pragma unroll
        for (int a = 0; a < 2; ++a)
#pragma unroll
            for (int b = 0; b < 2; ++b)
#pragma unroll
                for (int m = 0; m < 4; ++m)
#pragma unroll
                    for (int n = 0; n < 2; ++n) asm volatile("" : "+v"(acc[a][b][m][n]));
        asm volatile("s_nop 4" ::: "memory"); }
    bf16x8 At[4][2], B0[2][2], B1[2][2];
    i32x8 At8[4], B08[2], B18[2];
    int f8scale = 0x7f7f7f7f;
    if constexpr (FP8) asm volatile("v_mov_b32 %0, 0x7f7f7f7f\n\ts_nop 4" : "=v"(f8scale));
    const char* cA = cur.A; const char* cB = cur.B;
    S.a_ready(cur);
    PG8_STAGE_B(PG8_SB(0, 0), cB); PG8_STAGE_B(PG8_SB(0, 1), cB + hstepB); PG8_STAGE_AC(PG8_SA(0, 0), cA, 0); PG8_STAGE_AC(PG8_SA(0, 1), cA, 1);
    if (wr == 1) PG8_BAR;
    PG8_WAIT_V(2); PG8_BAR;
    PG8_STAGE_B(PG8_SB(1, 0), cB + kstep); PG8_STAGE_AC(PG8_SA(1, 0), cA + kstep, 0); PG8_STAGE_B(PG8_SB(1, 1), cB + hstepB + kstep);
    PG8_WAIT_V(6); PG8_BAR;
    for (;;) {
        const bool has_next = S.next(ui + 1, nxt);
        const char* nA = has_next ? nxt.A : cA; const char* nB = has_next ? nxt.B : cB;
        if constexpr (Sched::GATHER) {
            if (has_next) S.a_offsets(nxt, Ra, Ca, voffAn);
            else { voffAn[0][0] = voffAc[0][0]; voffAn[0][1] = voffAc[0][1]; voffAn[1][0] = voffAc[1][0]; voffAn[1][1] = voffAc[1][1]; }
        }
        const int nt = cur.nt;
        for (int t = 0; t < nt; t += 2) {
            const bool last = (t == nt - 2);
            if (last && has_next) S.a_ready(nxt);
            const char* a1 = cA + (size_t)(t + 1) * kstep;
            const char* a2 = last ? nA : cA + (size_t)(t + 2) * kstep; const char* b2 = last ? nB : cB + (size_t)(t + 2) * kstep;
            const char* a3 = a2 + kstep; const char* b3 = b2 + kstep;
            PG8_LDB(B0, 0, 0); PG8_LDB(B1, 0, 1); PG8_SCHED; PG8_LDA(At, 0, 0); PG8_STAGE_AC(PG8_SA(1, 1), a1, 1);
            PG8_WAIT_V(8); PG8_WAIT_L(0); PG8_BAR; PG8_MMA(0, 0, At, B0); PG8_MMA(0, 1, At, B1); PG8_BAR; PG8_SCHED;
            PG8_LDA(At, 0, 1); PG8_STAGE_B(PG8_SB(0, 0), b2); PG8_STAGE_B(PG8_SB(0, 1), b2 + hstepB); PG8_STAGE_AX(PG8_SA(0, 0), a2, 0);
            PG8_WAIT_V(8); PG8_WAIT_L(0); PG8_BAR; PG8_MMA(1, 0, At, B0); PG8_MMA(1, 1, At, B1); PG8_BAR; PG8_SCHED;
            PG8_LDB(B0, 1, 0); PG8_LDB(B1, 1, 1); PG8_SCHED; PG8_LDA(At, 1, 0); PG8_STAGE_AX(PG8_SA(0, 1), a2, 1);
            PG8_WAIT_V(8); PG8_WAIT_L(0); PG8_BAR; PG8_MMA(0, 0, At, B0); PG8_MMA(0, 1, At, B1); PG8_BAR; PG8_SCHED;
            PG8_LDA(At, 1, 1); PG8_STAGE_B(PG8_SB(1, 0), b3); PG8_STAGE_B(PG8_SB(1, 1), b3 + hstepB); PG8_STAGE_AX(PG8_SA(1, 0), a3, 0);
            PG8_WAIT_V(8); PG8_WAIT_L(0); PG8_BAR; PG8_MMA(1, 0, At, B0); PG8_MMA(1, 1, At, B1); PG8_BAR; PG8_SCHED;
        }
        if constexpr (ALIGN_EPI) { if (wr == 0) PG8_BAR; }
        if constexpr (FP8) { __builtin_amdgcn_sched_barrier(0); asm volatile("s_nop 15\n\ts_nop 7" ::: "memory"); __builtin_amdgcn_sched_barrier(0); }
        E(acc, cur, wr, wc, fr, fq); S.done(cur);
        if (!has_next) break;
        if (!(Epi::KEEP && cur.aux == 0))
#pragma unroll
        for (int a = 0; a < 2; ++a)
#pragma unroll
            for (int b = 0; b < 2; ++b)
#pragma unroll
                for (int m = 0; m < 4; ++m)
#pragma unroll
                    for (int n = 0; n < 2; ++n) acc[a][b][m][n] = (f32x4){0.f, 0.f, 0.f, 0.f};
        if constexpr (FP8) {
#pragma unroll
            for (int a = 0; a < 2; ++a)
#pragma unroll
                for (int b = 0; b < 2; ++b)
#pragma unroll
                    for (int m = 0; m < 4; ++m)
#pragma unroll
                        for (int n = 0; n < 2; ++n) asm volatile("" : "+v"(acc[a][b][m][n]));
            asm volatile("s_nop 4" ::: "memory"); }
        cur = nxt; cA = nA; cB = nB; ++ui;
        if constexpr (Sched::GATHER) { voffAc[0][0] = voffAn[0][0]; voffAc[0][1] = voffAn[0][1]; voffAc[1][0] = voffAn[1][0]; voffAc[1][1] = voffAn[1][1]; }
        if constexpr (ALIGN_EPI) { if (wr == 1) PG8_BAR; }
    }
    PG8_WAIT_V(0);
    if constexpr (!ALIGN_EPI) { if (wr == 0) PG8_BAR; }
    PG8_BAR;
#undef PG8_SA
#undef PG8_SB
#undef PG8_STAGE2
#undef PG8_STAGE_B
#undef PG8_STAGE_AC
#undef PG8_STAGE_AX
#undef PG8_LDA
#undef PG8_LDB
#undef PG8_MMA
#undef PG8_LD16
#undef PG8_WAIT_V
#undef PG8_WAIT_L
#undef PG8_BAR
#undef PG8_SCHED
}
}

#define XB_TMO      128
#define XB_XCNT(j)  (256  + 64 * (j))
#define XB_XSUB(j)  (1280 + 64 * (j))
#define XB_XGEN(j)  (2304 + 64 * (j))
#define XB_TOP      3328
#define XB_TOPGEN   3392
#define XCD_BAR_WORDS 3456
#define XB_SPIN_CAP (1u << 18)
__device__ __forceinline__ unsigned xb_ld(unsigned* p)              { return __hip_atomic_load(p, __ATOMIC_RELAXED, __HIP_MEMORY_SCOPE_AGENT); }
__device__ __forceinline__ unsigned xb_add(unsigned* p, unsigned v) { return __hip_atomic_fetch_add(p, v, __ATOMIC_RELAXED, __HIP_MEMORY_SCOPE_AGENT); }
__device__ __forceinline__ unsigned xb_xcc_id() { return (unsigned)__builtin_amdgcn_s_getreg((3 << 11) | 20) & 0xFu; }
#define XB_SPIN(cond, bar) do { unsigned _sp = 0; while (cond) { __builtin_amdgcn_s_sleep(1); \
    if ((++_sp & 255u) == 0u) { if (xb_ld(&(bar)[XB_TMO])) break; if (_sp > XB_SPIN_CAP) { atomicAdd(&(bar)[XB_TMO], 1u); break; } } } } while (0)
struct XcdBarrier { unsigned* bar; unsigned x; volatile LAS unsigned* st; };
__device__ __forceinline__ XcdBarrier xcd_barrier_post(unsigned* bar, volatile LAS unsigned* st) {
    XcdBarrier b; b.bar = bar; b.x = xb_xcc_id(); b.st = st;
    if (threadIdx.x == 0) (void)xb_add(&bar[XB_XCNT(b.x)], 1u);
    return b;
}
__device__ __forceinline__ void xcd_barrier_complete(unsigned* bar, unsigned x, unsigned& nloc, unsigned& nx) {
    const unsigned G = gridDim.x * gridDim.y * gridDim.z;
    unsigned sum, cnt, mine, sp = 0u;
    for (;;) {
        sum = 0u; cnt = 0u; mine = 0u;
#pragma unroll
        for (unsigned j = 0; j < 16; ++j) { const unsigned c = xb_ld(&bar[XB_XCNT(j)]); sum += c; cnt += (c > 0u) ? 1u : 0u; mine = (j == x) ? c : mine; }
        if (sum == G) break;
        __builtin_amdgcn_s_sleep(1);
        if ((++sp & 255u) == 0u) { if (xb_ld(&bar[XB_TMO])) break; if (sp > XB_SPIN_CAP) { atomicAdd(&bar[XB_TMO], 1u); break; } }
    }
    nloc = mine > 0u ? mine : 1u; nx = cnt > 0u ? cnt : 1u;
}
template <bool PF = false> __device__ __forceinline__ void xcd_barrier(const XcdBarrier& b, unsigned long long code_pc = 0, unsigned code_len = 0, unsigned xq = 0) {
    asm volatile("s_waitcnt vmcnt(0)" ::: "memory");
    __syncthreads();
    if (PF && threadIdx.x >= 64) {
        const unsigned sl_ = ((code_len >> 5) + 8191u) & ~8191u;
#pragma unroll
        for (int r_ = 0; r_ < 2; ++r_) { if (r_ == 1 && threadIdx.x >= 128) break;
            const unsigned o0_ = xq * sl_ + (threadIdx.x - 64u * r_) * 16u; u32x4 t0_, t1_;
            const char* a0_ = (const char*)code_pc + ((o0_ + 16u <= code_len) ? o0_ : 0u); const char* a1_ = (const char*)code_pc + ((o0_ + 8192u + 16u <= code_len && sl_ > 8192u) ? o0_ + 8192u : 0u);
            asm volatile("global_load_dwordx4 %0, %2, off\n\tglobal_load_dwordx4 %1, %3, off\n\ts_waitcnt vmcnt(0)" : "=&v"(t0_), "=&v"(t1_) : "v"(a0_), "v"(a1_) : "memory"); } }
    if (threadIdx.x == 0) {
        unsigned* bar = b.bar;
        __builtin_amdgcn_s_waitcnt(0);
        unsigned nloc = b.st[0], nx = b.st[1];
        if (nloc == 0u) { xcd_barrier_complete(bar, b.x, nloc, nx); b.st[0] = nloc; b.st[1] = nx; }
        const unsigned old = xb_add(&bar[XB_XSUB(b.x)], 1u);
        const unsigned gen = old / nloc;
        if (old + 1u == (gen + 1u) * nloc) {
            __builtin_amdgcn_fence(__ATOMIC_RELEASE, "agent");
            asm volatile("s_waitcnt vmcnt(0)" ::: "memory");
            const unsigned og = xb_add(&bar[XB_TOP], 1u);
            const unsigned tg = og / nx;
            if (og + 1u == (tg + 1u) * nx) xb_add(&bar[XB_TOPGEN], 1u);
            else XB_SPIN(xb_ld(&bar[XB_TOPGEN]) == tg, bar);
            __builtin_amdgcn_fence(__ATOMIC_ACQUIRE, "agent");
            xb_add(&bar[XB_XGEN(b.x)], 1u);
            asm volatile("s_waitcnt vmcnt(0)" ::: "memory");
        } else {
            XB_SPIN(xb_ld(&bar[XB_XGEN(b.x)]) == gen, bar);
            __builtin_amdgcn_fence(__ATOMIC_ACQUIRE, "agent");
            asm volatile("s_waitcnt vmcnt(0)" ::: "memory");
        }
    }
    __syncthreads();
}

constexpr int NWAVES = 8;
constexpr int RING_OFF = 0, RING_BYTES = 131072;
constexpr int LDSCTL_OFF = RING_BYTES, MISC_OFF = LDSCTL_OFF + 320;
constexpr int LDS_BYTES = 147456;
constexpr int LRU_PRE_OFF = 132096, LRU_SG4_OFF = 119808;
constexpr int CW_BAR = 4096;

#define LDS_WAIT() asm volatile("s_waitcnt lgkmcnt(0)" ::: "memory")
#define VM_WAIT() asm volatile("s_waitcnt vmcnt(0)" ::: "memory")

struct Args { P p; int ph_lo, ph_hi, li, pad; };

__device__ __forceinline__ int lane_now() { int l; asm volatile("v_mbcnt_lo_u32_b32 %0, -1, 0\n\tv_mbcnt_hi_u32_b32 %0, -1, %0" : "=v"(l)); return l; }
__device__ __forceinline__ float wave_sum(float v) {
#pragma unroll
    for (int o = 1; o < 64; o <<= 1) v += __shfl_xor(v, o);
    return v;
}
__device__ __forceinline__ void x_ldrow(const float* x, int m, int lane, f32x4 (&v)[8]) {
    const GAS f32x4* xr = (const GAS f32x4*)(x + (size_t)m * D) + lane;
#pragma unroll
    for (int j = 0; j < 8; ++j) v[j] = __builtin_nontemporal_load(xr + 64 * j);
}
__device__ __forceinline__ void x_strow(bf16* XB, unsigned* XF8, float* rstd1, int m, int lane, const f32x4 (&v)[8]) {
    float s = 0.f;
#pragma unroll
    for (int j = 0; j < 8; ++j) s += (v[j].x * v[j].x + v[j].y * v[j].y) + (v[j].z * v[j].z + v[j].w * v[j].w);
    s = wave_sum(s);
    if (lane == 0) rstd1[m] = rsqrtf(s * (1.f / D) + EPS);
    GAS u32x2* o8 = (GAS u32x2*)(XB + (size_t)m * D) + lane;
#pragma unroll
    for (int j = 0; j < 8; ++j) { u32x2 w; w.x = cvt_pk_bf16(v[j].x, v[j].y); w.y = cvt_pk_bf16(v[j].z, v[j].w); o8[64 * j] = w; }
    GAS unsigned* o4 = (GAS unsigned*)(XF8 + (size_t)m * (D / 4)) + lane;
#pragma unroll
    for (int j = 0; j < 8; ++j) { unsigned w = 0; w = F8PK(v[j].x, v[j].y, w, false); w = F8PK(v[j].z, v[j].w, w, true); o4[64 * j] = w; }
}
struct TItem { const float* src; bf16* dst; const float* ks; int ldw, ldk; };
template <bool HAS_KS> __device__ __forceinline__ void t_load(const TItem& t, int lane, f32x4 (&v)[8], float (&kv)[8]) {
    const int r8 = lane >> 3, c8 = lane & 7;
#pragma unroll
    for (int i = 0; i < 8; ++i) { v[i] = __builtin_nontemporal_load((const GAS f32x4*)(t.src + (size_t)(8 * i + r8) * t.ldw + 4 * c8)); if (HAS_KS) kv[i] = t.ks[8 * i + r8]; else kv[i] = 1.f; }
}
template <bool F8 = false, bool NT = false> __device__ __forceinline__ void t_store(const TItem& t, int lane, const f32x4 (&v)[8], const float (&kv)[8], LAS float* scr) {
    const int r8 = lane >> 3, c8 = lane & 7;
#pragma unroll
    for (int i = 0; i < 8; ++i) {
#pragma unroll
        for (int e = 0; e < 4; ++e) scr[(4 * c8 + e) * 65 + 8 * i + r8] = v[i][e] * kv[i]; }
    LDS_WAIT(); asm volatile("" ::: "memory");
#pragma unroll
    for (int j = 0; j < 4; ++j) { const int n = r8 + 8 * j; const LAS float* sp = scr + n * 65 + 8 * c8;
        if constexpr (F8) {
            u32x2 o; unsigned w = 0; w = F8PK(sp[0] * 64.f, sp[1] * 64.f, w, false); w = F8PK(sp[2] * 64.f, sp[3] * 64.f, w, true); o.x = w;
            w = 0; w = F8PK(sp[4] * 64.f, sp[5] * 64.f, w, false); w = F8PK(sp[6] * 64.f, sp[7] * 64.f, w, true); o.y = w;
            if constexpr (NT) __builtin_nontemporal_store(o, (GAS u32x2*)((unsigned char*)t.dst + (size_t)n * t.ldk + 8 * c8)); else *(GAS u32x2*)((unsigned char*)t.dst + (size_t)n * t.ldk + 8 * c8) = o; }
        else {
        u32x4 o; o.x = cvt_pk_bf16(sp[0], sp[1]); o.y = cvt_pk_bf16(sp[2], sp[3]); o.z = cvt_pk_bf16(sp[4], sp[5]); o.w = cvt_pk_bf16(sp[6], sp[7]);
        if constexpr (NT) __builtin_nontemporal_store(o, (GAS u32x4*)(t.dst + (size_t)n * t.ldk + 8 * c8)); else *(GAS u32x4*)(t.dst + (size_t)n * t.ldk + 8 * c8) = o; } }
    LDS_WAIT(); asm volatile("" ::: "memory");
}
template <int KIND> struct TKind;
template <> struct TKind<0> { static constexpr int N = (D / 64) * (3584 / 32); static constexpr bool KS = true; };
template <> struct TKind<8> { static constexpr int N = (D / 64) * (4096 / 32); static constexpr bool KS = true; };
template <> struct TKind<1> { static constexpr int N = (S5W / 64) * (S5W / 32); static constexpr bool KS = false; };
template <> struct TKind<2> { static constexpr int N = LH * 2 * 8; static constexpr bool KS = false; };
template <> struct TKind<3> { static constexpr int N = (D / 64) * (D / 32); static constexpr bool KS = false; };
template <> struct TKind<4> { static constexpr int N = (D / 64) * (D / 32); static constexpr bool KS = false; };
template <> struct TKind<5> { static constexpr int N = NE * 256; static constexpr bool KS = true; };
template <> struct TKind<6> { static constexpr int N = NE * 256; static constexpr bool KS = true; };
template <> struct TKind<7> { static constexpr int N = NE * 256; static constexpr bool KS = false; };
template <int KIND> __device__ __forceinline__ void t_decode(const P& p, int it, TItem& t) {
    unsigned char* ws = p.ws;
    if constexpr (KIND == 8) { const int kb = it / 128, nb = it % 128; t.src = p.w_in + (size_t)(64 * kb) * INC + 3584 + 32 * nb; t.ldw = INC; t.dst = (bf16*)(ws + WS_WG8 + (size_t)(32 * nb) * D + 64 * kb); t.ldk = D; t.ks = p.norm_mix_w + 64 * kb; }
    if constexpr (KIND == 0) { const int kb = it / (3584 / 32), nb = it % (3584 / 32); t.src = p.w_in + (size_t)(64 * kb) * INC + 32 * nb; t.ldw = INC; t.dst = (bf16*)(ws + WS_WINT) + (size_t)(32 * nb) * D + 64 * kb; t.ldk = D; t.ks = p.norm_mix_w + 64 * kb; }
    if constexpr (KIND == 1) { const int kb = it / (S5W / 32), nb = it % (S5W / 32); t.src = p.s5_w_glu + (size_t)(64 * kb) * S5W + 32 * nb; t.ldw = S5W; t.dst = (bf16*)(ws + WS_WGLUT) + (size_t)(32 * nb) * S5W + 64 * kb; t.ldk = S5W; t.ks = nullptr; }
    if constexpr (KIND == 2) { const int hg = it >> 3, sub = it & 7, hh = hg >> 1, gt = hg & 1, kb = sub >> 2, nb = sub & 3;
        const float* wa_ = p.lru_w_a; const float* wx_ = p.lru_w_x; asm volatile("" : "+s"(wa_), "+s"(wx_));
        t.src = (gt ? wx_ : wa_) + (size_t)hh * 128 * 128 + (size_t)(64 * kb) * 128 + 32 * nb; t.ldw = 128;
        t.dst = (bf16*)(ws + WS_WLT) + (size_t)(hh * 256 + gt * 128 + 32 * nb) * 128 + 64 * kb; t.ldk = 128; t.ks = nullptr; }
    if constexpr (KIND == 3) { const int kb = it / (D / 32), nb = it % (D / 32); t.ldw = D; t.ldk = D; t.ks = nullptr;
        const float* w5_ = p.w_proj_s5; const float* wl_ = p.w_proj_lru - (size_t)S5W * D; asm volatile("" : "+s"(w5_), "+s"(wl_));
        t.src = (kb < S5W / 64 ? w5_ : wl_) + (size_t)(64 * kb) * D + 32 * nb; t.dst = (bf16*)(ws + WS_WPT + (size_t)(32 * nb) * D + 64 * kb); }
    if constexpr (KIND == 4) { const int kb = it / (D / 32), nb = it % (D / 32); t.ldw = D; t.ldk = D; t.ks = nullptr;
        t.src = p.w_out + (size_t)(64 * kb) * D + 32 * nb; t.dst = (bf16*)(ws + WS_WOUTT + (size_t)(32 * nb) * D + 64 * kb); }
    if constexpr (KIND == 5 || KIND == 6) { const int e = it >> 8, q = it & 255, kb = q >> 3, nb = q & 7, n0 = 32 * nb;
        t.src = (KIND == 6 ? p.w_e_up : p.w_e_gate) + (size_t)e * D * EFF + (size_t)(64 * kb) * EFF + n0; t.ldw = EFF;
        t.dst = (bf16*)(ws + WS_WGUT + (size_t)(e * 512 + (n0 >> 7) * 256 + (KIND == 6 ? 128 : 0) + (n0 & 127)) * D + 64 * kb); t.ldk = D; t.ks = p.norm_ffn_w + 64 * kb; }
    if constexpr (KIND == 7) { const int e = it >> 8, q = it & 255, kb = q >> 6, nb = q & 63;
        t.src = p.w_e_down + (size_t)e * EFF * D + (size_t)(64 * kb) * D + 32 * nb; t.ldw = D;
        t.dst = (bf16*)(ws + WS_WDT) + (size_t)(e * D + 32 * nb) * EFF + 64 * kb; t.ldk = EFF; t.ks = nullptr; }
}
template <int KIND> __device__ __forceinline__ void t_ld(const P& p, int it, int lane, f32x4 (&v)[8], float (&kv)[8]) { TItem t; t_decode<KIND>(p, it, t); t_load<TKind<KIND>::KS>(t, lane, v, kv); }
template <int KIND> __device__ __forceinline__ void t_st(const P& p, int it, int lane, const f32x4 (&v)[8], const float (&kv)[8], LAS float* scr) { TItem t; t_decode<KIND>(p, it, t); t_store<KIND == 8 || KIND == 5 || KIND == 6 || KIND == 4 || KIND == 3, (KIND >= 3 && KIND <= 7)>(t, lane, v, kv, scr); }
template <int KIND> __device__ __forceinline__ void t_run(const P& p, int first, int stride, int lane, LAS float* scr, int lo = 0, int hi = TKind<KIND>::N) {
    const int N = hi;
    f32x4 va[8], vb[8]; float ka[8], kb[8];
    int it = lo + first; if (it >= N) return;
    t_ld<KIND>(p, it, lane, va, ka);
    for (;;) {
        const bool hb = it + stride < N;
        if (hb) t_ld<KIND>(p, it + stride, lane, vb, kb);
        t_st<KIND>(p, it, lane, va, ka, scr);
        if (!hb) break;
        it += stride;
        const bool ha = it + stride < N;
        if (ha) t_ld<KIND>(p, it + stride, lane, va, ka);
        t_st<KIND>(p, it, lane, vb, kb, scr);
        if (!ha) break;
        it += stride;
    }
}

__device__ __forceinline__ void unpack8(const u32x4 w, f32x4& a, f32x4& b) {
    a[0] = __uint_as_float(w.x << 16); a[1] = __uint_as_float(w.x & 0xffff0000u); a[2] = __uint_as_float(w.y << 16); a[3] = __uint_as_float(w.y & 0xffff0000u);
    b[0] = __uint_as_float(w.z << 16); b[1] = __uint_as_float(w.z & 0xffff0000u); b[2] = __uint_as_float(w.w << 16); b[3] = __uint_as_float(w.w & 0xffff0000u); }
__device__ __forceinline__ void unpack8u(const u32x2 w, f32x4& a, f32x4& b) {
    a[0] = (float)(w.x & 0xffu); a[1] = (float)((w.x >> 8) & 0xffu); a[2] = (float)((w.x >> 16) & 0xffu); a[3] = (float)(w.x >> 24);
    b[0] = (float)(w.y & 0xffu); b[1] = (float)((w.y >> 8) & 0xffu); b[2] = (float)((w.y >> 16) & 0xffu); b[3] = (float)(w.y >> 24); }
__device__ __forceinline__ u32x2 pk8_e4m3(const f32x4 v0, const f32x4 v1) { u32x2 w; unsigned a_ = 0, b_ = 0;
    a_ = F8PK(v0[0], v0[1], a_, false); a_ = F8PK(v0[2], v0[3], a_, true); b_ = F8PK(v1[0], v1[1], b_, false); b_ = F8PK(v1[2], v1[3], b_, true); w.x = a_; w.y = b_; return w; }
__device__ __forceinline__ u32x4 pair16(const u32x2 a, const u32x2 b) {
    const auto rx = __builtin_amdgcn_permlane16_swap(a.x, b.x, false, false);
    const auto ry = __builtin_amdgcn_permlane16_swap(a.y, b.y, false, false);
    return (u32x4){(unsigned)rx[0], (unsigned)ry[0], (unsigned)rx[1], (unsigned)ry[1]};
}
__device__ __forceinline__ void unpair16(const u32x4 q, u32x2& a, u32x2& b) {
    const auto rx = __builtin_amdgcn_permlane16_swap(q.x, q.z, false, false);
    const auto ry = __builtin_amdgcn_permlane16_swap(q.y, q.w, false, false);
    a.x = rx[0]; a.y = ry[0]; b.x = rx[1]; b.y = ry[1];
}
__device__ __forceinline__ void st16_wt(void* p, u32x4 v) { asm volatile("global_store_dwordx4 %0, %1, off sc1\n\ts_nop 1" :: "v"(p), "v"(v) : "memory"); }
constexpr float GSC = 254.49f;
struct EpiInproj {
    static constexpr bool PERM = true; static constexpr bool KEEP = false;
    const float* rstd; const float* b_gate; bf16* U5; bf16* XL; bf16* GY; bf16* GATES;
    __device__ __forceinline__ void operator()(const f32x4 (&acc)[2][2][4][2], const pg8::Unit& u, int wr, int wc, int fr, int fq) const {
        const int row0 = u.pm * 256 + wr * 64 + fr, pn = u.pn, colb = wc * 32 + 8 * fq;
        f32x4 bv[2][2];
#pragma unroll
        for (int bj = 0; bj < 2; ++bj)
#pragma unroll
            for (int n = 0; n < 2; ++n) bv[bj][n] = (pn >= 14) ? *(const f32x4*)(b_gate + (pn * 256 + bj * 128 + colb - 3584) + 4 * n) * -1.4426950408889634f : (f32x4){0.f, 0.f, 0.f, 0.f};
        if (pn >= 14) {
            const int odd = fq & 1;
#pragma unroll
            for (int ai = 0; ai < 2; ++ai)
#pragma unroll
                for (int mp = 0; mp < 4; mp += 2) {
                    const int ra = row0 + ai * 128 + mp * 16, rb = ra + 16;
                    const float na = rstd[ra] * (-1.4426950408889634f / 64.f), nb = rstd[rb] * (-1.4426950408889634f / 64.f);
#pragma unroll
                    for (int bj = 0; bj < 2; ++bj) { u32x2 qa, qb; qa.x = 0u; qa.y = 0u; qb.x = 0u; qb.y = 0u;
#pragma unroll
                        for (int e = 0; e < 4; ++e) {
                            const float a0 = __builtin_amdgcn_rcpf(1.f + __builtin_amdgcn_exp2f(__builtin_fmaf(acc[ai][bj][mp][0][e], na, bv[bj][0][e])));
                            const float a1 = __builtin_amdgcn_rcpf(1.f + __builtin_amdgcn_exp2f(__builtin_fmaf(acc[ai][bj][mp][1][e], na, bv[bj][1][e])));
                            const float b0 = __builtin_amdgcn_rcpf(1.f + __builtin_amdgcn_exp2f(__builtin_fmaf(acc[ai][bj][mp + 1][0][e], nb, bv[bj][0][e])));
                            const float b1 = __builtin_amdgcn_rcpf(1.f + __builtin_amdgcn_exp2f(__builtin_fmaf(acc[ai][bj][mp + 1][1][e], nb, bv[bj][1][e])));
                            qa.x = __builtin_amdgcn_cvt_pk_u8_f32(fmaxf(__builtin_fmaf(a0, GSC, 0.5f), 1.f), e, qa.x); qa.y = __builtin_amdgcn_cvt_pk_u8_f32(fmaxf(__builtin_fmaf(a1, GSC, 0.5f), 1.f), e, qa.y);
                            qb.x = __builtin_amdgcn_cvt_pk_u8_f32(fmaxf(__builtin_fmaf(b0, GSC, 0.5f), 1.f), e, qb.x); qb.y = __builtin_amdgcn_cvt_pk_u8_f32(fmaxf(__builtin_fmaf(b1, GSC, 0.5f), 1.f), e, qb.y); }
                        *(u32x4*)((unsigned char*)GATES + (size_t)(odd ? rb : ra) * 4096 + (pn * 256 + bj * 128 + colb - 3584) - 8 * odd) = pair16(qa, qb); } }
            return; }
#pragma unroll
        for (int ai = 0; ai < 2; ++ai)
#pragma unroll
            for (int m = 0; m < 4; ++m) {
                const int row = row0 + ai * 128 + m * 16; const float rs = rstd[row] * ((pn >= 14) ? (1.f / 64.f) : 1.f);
#pragma unroll
                for (int bj = 0; bj < 2; ++bj) {
                    const int col = pn * 256 + bj * 128 + colb;
                    f32x4 v0 = acc[ai][bj][m][0] * rs, v1 = acc[ai][bj][m][1] * rs; bf16* dst;
                    if (pn < 2) { dst = U5 + ((size_t)(col >> 4) * NCH + (row >> 5)) * S5KT + (row & 31) * 16 + (col & 15); }
                    else if (pn < 8) { dst = XL + (size_t)row * LW + (col - 512); }
                    else if (pn < 14) { dst = GY + (size_t)row * LW + (col - 2048);
#pragma unroll
                        for (int e = 0; e < 4; ++e) { v0[e] = fgelu(v0[e]); v1[e] = fgelu(v1[e]); } }
                    else {
                        const float nrs = rs * -1.4426950408889634f; u32x2 wq; wq.x = 0u; wq.y = 0u;
#pragma unroll
                        for (int e = 0; e < 4; ++e) {
                            const float g0 = __builtin_amdgcn_rcpf(1.f + __builtin_amdgcn_exp2f(__builtin_fmaf(acc[ai][bj][m][0][e], nrs, bv[bj][0][e])));
                            const float g1 = __builtin_amdgcn_rcpf(1.f + __builtin_amdgcn_exp2f(__builtin_fmaf(acc[ai][bj][m][1][e], nrs, bv[bj][1][e])));
                            wq.x = __builtin_amdgcn_cvt_pk_u8_f32(fmaxf(__builtin_fmaf(g0, GSC, 0.5f), 1.f), e, wq.x); wq.y = __builtin_amdgcn_cvt_pk_u8_f32(fmaxf(__builtin_fmaf(g1, GSC, 0.5f), 1.f), e, wq.y); }
                        *(u32x2*)((unsigned char*)GATES + (size_t)row * 4096 + (col - 3584)) = wq; continue; }
                    u32x4 w; w.x = cvt_pk_bf16(v0[0], v0[1]); w.y = cvt_pk_bf16(v0[2], v0[3]); w.z = cvt_pk_bf16(v1[0], v1[1]); w.w = cvt_pk_bf16(v1[2], v1[3]);
                    *(u32x4*)dst = w;
                }
            }
    }
};


struct Fp8Order {
    static constexpr bool GATHER = false;
    pg8::PlainOrder po; int w0, wstep, wn;
    __device__ bool next(int i, pg8::Unit& u) const { if (i >= wn || !po.next_L(w0 + i * wstep, u)) return false; u.pn += 14; return true; }
    __device__ __forceinline__ void a_offsets(const pg8::Unit&, const int (&)[2], const int (&)[2], unsigned (&)[2][2]) const {}
    __device__ __forceinline__ void a_ready(const pg8::Unit&) const {}
    __device__ __forceinline__ void done(const pg8::Unit&) const {}
};

struct S5EOrder {
    static constexpr bool GATHER = false;
    int G, c, lim; const char* A; const char* B;
    __device__ bool next(int i, pg8::Unit& u) const {
        const int L = i * G + c; if (L >= lim) return false;
        const int g = L >> 1; u.pm = L & 1; u.pn = 0; u.aux = g; u.nt = S5KU / 64;
        u.A = A + ((size_t)(g * NCH + 256 * u.pm) * S5KT) * 2; u.B = B + (size_t)g * 128 * S5KU * 2; return true; }
    __device__ __forceinline__ void a_offsets(const pg8::Unit&, const int (&)[2], const int (&)[2], unsigned (&)[2][2]) const {}
    __device__ __forceinline__ void a_ready(const pg8::Unit&) const {}
    __device__ __forceinline__ void done(const pg8::Unit&) const {}
};
struct EpiS5E {
    static constexpr bool PERM = false; static constexpr bool KEEP = false;
    float* SEND;
    __device__ __forceinline__ void operator()(const f32x4 (&acc)[2][2][4][2], const pg8::Unit& u, int wr, int wc, int fr, int fq) const {
        const int row0 = u.pm * 256 + wr * 64 + fr, col0 = wc * 32 + 4 * fq;
#pragma unroll
        for (int ai = 0; ai < 2; ++ai)
#pragma unroll
            for (int m = 0; m < 4; ++m) { float* rp = SEND + ((size_t)u.aux * NCH + row0 + ai * 128 + m * 16) * 128 + col0;
#pragma unroll
                for (int n = 0; n < 2; ++n) *(f32x4*)(rp + n * 16) = acc[ai][0][m][n]; }
    }
};
struct S5COrder {
    static constexpr bool GATHER = false;
    int G, c, lim; const char* A; const char* B;
    __device__ bool next(int i, pg8::Unit& u) const {
        const int L = i * G + c; if (L >= lim) return false;
        const int g = L >> 2; u.pm = (L >> 1) & 1; u.pn = L & 1; u.aux = g; u.nt = S5KT / 64;
        u.A = A + ((size_t)(g * NCH + 256 * u.pm) * S5KT) * 2; u.B = B + ((size_t)(g * S5KU + 256 * u.pn) * S5KT) * 2; return true; }
    __device__ __forceinline__ void a_offsets(const pg8::Unit&, const int (&)[2], const int (&)[2], unsigned (&)[2][2]) const {}
    __device__ __forceinline__ void a_ready(const pg8::Unit&) const {}
    __device__ __forceinline__ void done(const pg8::Unit&) const {}
};
struct EpiS5C {
    static constexpr bool PERM = true; static constexpr bool KEEP = false;
    const bf16* U5X; const float* dskip; bf16* Y5;
    __device__ __forceinline__ void operator()(const f32x4 (&acc)[2][2][4][2], const pg8::Unit& u, int wr, int wc, int fr, int fq) const {
        const int g = u.aux, row0 = u.pm * 256 + wr * 64 + fr, colb = u.pn * 256 + wc * 32 + 8 * fq;
#pragma unroll
        for (int bj = 0; bj < 2; ++bj) {
            const int n0 = colb + bj * 128, ti = n0 >> 4, c0 = n0 & 15;
            const f32x4 d0 = *(const f32x4*)(dskip + g * 16 + c0), d1 = *(const f32x4*)(dskip + g * 16 + c0 + 4);
            u32x4 uw[2][4];
#pragma unroll
            for (int ai = 0; ai < 2; ++ai)
#pragma unroll
                for (int m = 0; m < 4; ++m) uw[ai][m] = *(const u32x4*)(U5X + ((size_t)g * NCH + row0 + ai * 128 + m * 16) * S5KT + n0);
#pragma unroll
            for (int ai = 0; ai < 2; ++ai)
#pragma unroll
                for (int m = 0; m < 4; ++m) {
                    const int j = row0 + ai * 128 + m * 16;
                    f32x4 u0, u1; unpack8(uw[ai][m], u0, u1);
                    f32x4 v0 = acc[ai][bj][m][0] + d0 * u0, v1 = acc[ai][bj][m][1] + d1 * u1;
#pragma unroll
                    for (int e = 0; e < 4; ++e) { v0[e] = fgelu(v0[e]); v1[e] = fgelu(v1[e]); }
                    u32x4 w; w.x = cvt_pk_bf16(v0[0], v0[1]); w.y = cvt_pk_bf16(v0[2], v0[3]); w.z = cvt_pk_bf16(v1[0], v1[1]); w.w = cvt_pk_bf16(v1[2], v1[3]);
                    *(u32x4*)(Y5 + (size_t)(j * LC + ti) * S5W + g * 16 + c0) = w;
                }
            asm volatile("" ::: "memory");
        }
    }
};
struct EpiGlu {
    static constexpr bool PERM = true; static constexpr bool KEEP = false;
    const bf16* Y5; const float* bias; bf16* OUTC;
    __device__ __forceinline__ void operator()(const f32x4 (&acc)[2][2][4][2], const pg8::Unit& u, int wr, int wc, int fr, int fq) const {
        const int row0 = u.pm * 256 + wr * 64 + fr, colb = u.pn * 256 + wc * 32 + 8 * fq;
#pragma unroll
        for (int bj = 0; bj < 2; ++bj) {
            const int col = colb + bj * 128;
            const f32x4 b0 = *(const f32x4*)(bias + col), b1 = *(const f32x4*)(bias + col + 4);
            u32x4 yw[2][4];
#pragma unroll
            for (int ai = 0; ai < 2; ++ai)
#pragma unroll
                for (int m = 0; m < 4; ++m) yw[ai][m] = *(const u32x4*)(Y5 + (size_t)(row0 + ai * 128 + m * 16) * S5W + col);
#pragma unroll
            for (int ai = 0; ai < 2; ++ai)
#pragma unroll
                for (int m = 0; m < 4; ++m) {
                    f32x4 y0, y1; unpack8(yw[ai][m], y0, y1);
                    f32x4 v0 = acc[ai][bj][m][0] + b0, v1 = acc[ai][bj][m][1] + b1;
#pragma unroll
                    for (int e = 0; e < 4; ++e) { v0[e] = y0[e] * fsig(v0[e]); v1[e] = y1[e] * fsig(v1[e]); }
                    u32x2 w; { unsigned w_ = 0; w_ = F8PK(v0[0] * 16.f, v0[1] * 16.f, w_, false); w_ = F8PK(v0[2] * 16.f, v0[3] * 16.f, w_, true); w.x = w_; }
                    { unsigned w_ = 0; w_ = F8PK(v1[0] * 16.f, v1[1] * 16.f, w_, false); w_ = F8PK(v1[2] * 16.f, v1[3] * 16.f, w_, true); w.y = w_; }
                    *(u32x2*)((unsigned char*)OUTC + (size_t)(row0 + ai * 128 + m * 16) * D + col) = w;
                }
            asm volatile("" ::: "memory");
        }
    }
};

struct EpiProj {
    static constexpr bool PERM = true; static constexpr bool KEEP = true;
    const bf16* GATES; bf16* MERGED;
    __device__ __forceinline__ void operator()(f32x4 (&acc)[2][2][4][2], const pg8::Unit& u, int wr, int wc, int fr, int fq) const {
        const int row0 = u.pm * 256 + wr * 64 + fr, colb = u.pn * 256 + wc * 32 + 8 * fq;
        if (u.aux == 0) {
#pragma unroll
            for (int ai = 0; ai < 2; ++ai)
#pragma unroll
                for (int mh = 0; mh < 2; ++mh) {
                    u32x2 sw[2][2], lw[2][2]; u32x4 sq[2], lq[2]; const int odd = fq & 1;
#pragma unroll
                    for (int bj = 0; bj < 2; ++bj) { const unsigned char* gp = (const unsigned char*)GATES + (size_t)(row0 + ai * 128 + (2 * mh + odd) * 16) * 4096 + colb - 8 * odd + bj * 128; sq[bj] = *(const u32x4*)gp; lq[bj] = *(const u32x4*)(gp + 2048); }
#pragma unroll
                    for (int bj = 0; bj < 2; ++bj) { unpair16(sq[bj], sw[0][bj], sw[1][bj]); unpair16(lq[bj], lw[0][bj], lw[1][bj]); }
#pragma unroll
                    for (int mm = 0; mm < 2; ++mm)
#pragma unroll
                        for (int bj = 0; bj < 2; ++bj) { const int m = 2 * mh + mm; f32x4 s0, s1, l0, l1; unpack8u(sw[mm][bj], s0, s1); unpack8u(lw[mm][bj], l0, l1);
#pragma unroll
                            for (int e = 0; e < 4; ++e) { acc[ai][bj][m][0][e] *= s0[e] * __builtin_amdgcn_rcpf(l0[e]); acc[ai][bj][m][1][e] *= s1[e] * __builtin_amdgcn_rcpf(l1[e]); } }
                    asm volatile("" ::: "memory"); }
            return; }
#pragma unroll
        for (int ai = 0; ai < 2; ++ai) {
            u32x2 lw[4][2]; u32x4 lq[2][2]; const int oddl = fq & 1;
#pragma unroll
            for (int mq = 0; mq < 2; ++mq)
#pragma unroll
                for (int bj = 0; bj < 2; ++bj) lq[mq][bj] = *(const u32x4*)((const unsigned char*)GATES + (size_t)(row0 + ai * 128 + (2 * mq + oddl) * 16) * 4096 + 2048 + colb - 8 * oddl + bj * 128);
#pragma unroll
            for (int mq = 0; mq < 2; ++mq)
#pragma unroll
                for (int bj = 0; bj < 2; ++bj) unpair16(lq[mq][bj], lw[2 * mq][bj], lw[2 * mq + 1][bj]);
#pragma unroll
            for (int mp = 0; mp < 4; mp += 2)
#pragma unroll
                for (int bj = 0; bj < 2; ++bj) { f32x4 l0, l1, k0, k1; unpack8u(lw[mp][bj], l0, l1); unpack8u(lw[mp + 1][bj], k0, k1);
                    const u32x2 wa = pk8_e4m3(acc[ai][bj][mp][0] * l0 * (1.f / (64.f * GSC)), acc[ai][bj][mp][1] * l1 * (1.f / (64.f * GSC)));
                    const u32x2 wb = pk8_e4m3(acc[ai][bj][mp + 1][0] * k0 * (1.f / (64.f * GSC)), acc[ai][bj][mp + 1][1] * k1 * (1.f / (64.f * GSC)));
                    const int odd = fq & 1;
                    *(u32x4*)((unsigned char*)MERGED + (size_t)(row0 + ai * 128 + (mp + odd) * 16) * D + colb - 8 * odd + bj * 128) = pair16(wa, wb); }
            asm volatile("" ::: "memory"); }
    }
};
struct ProjOrder {
    static constexpr bool GATHER = false;
    pg8::PlainOrder po;
    __device__ bool next(int i, pg8::Unit& u) const {
        if (!po.next(i >> 1, u)) return false;
        if (i & 1) { u.A += S5W; u.B += S5W; u.nt = LW / 128; u.aux = 1; } else { u.nt = S5W / 128; u.aux = 0; }
        return true; }
    __device__ __forceinline__ void a_offsets(const pg8::Unit&, const int (&)[2], const int (&)[2], unsigned (&)[2][2]) const {}
    __device__ __forceinline__ void a_ready(const pg8::Unit&) const {}
    __device__ __forceinline__ void done(const pg8::Unit&) const {}
};
struct EpiWout {
    static constexpr bool PERM = true; static constexpr bool KEEP = false;
    bf16* DELTA; const bf16* XB;
    __device__ __forceinline__ void operator()(const f32x4 (&acc)[2][2][4][2], const pg8::Unit& u, int wr, int wc, int fr, int fq) const {
        const int row0 = u.pm * 256 + wr * 64 + fr, col0 = u.pn * 256 + wc * 32 + 8 * fq;
        const bf16* __restrict__ xb = XB; bf16* __restrict__ dl = DELTA;
#pragma unroll
        for (int ai = 0; ai < 2; ++ai) {
            u32x4 xw[4][2];
#pragma unroll
            for (int m = 0; m < 4; ++m)
#pragma unroll
                for (int bj = 0; bj < 2; ++bj) xw[m][bj] = __builtin_nontemporal_load((const u32x4*)(xb + (size_t)(row0 + ai * 128 + m * 16) * D + col0 + bj * 128));
#pragma unroll
            for (int m = 0; m < 4; ++m)
#pragma unroll
                for (int bj = 0; bj < 2; ++bj) { f32x4 x0, x1; unpack8(xw[m][bj], x0, x1);
                    const f32x4 v0 = acc[ai][bj][m][0] * (1.f / 1024.f) + x0, v1 = acc[ai][bj][m][1] * (1.f / 1024.f) + x1;
                    u32x4 w; w.x = cvt_pk_bf16(v0[0], v0[1]); w.y = cvt_pk_bf16(v0[2], v0[3]); w.z = cvt_pk_bf16(v1[0], v1[1]); w.w = cvt_pk_bf16(v1[2], v1[3]);
                    *(u32x4*)(dl + (size_t)(row0 + ai * 128 + m * 16) * D + col0 + bj * 128) = w; }
            asm volatile("" ::: "memory"); }
    }
};

__device__ __forceinline__ void s5_tables(const P& p, LAS f32x2* LPW, LAS f32x2* CC, LAS f32x2* BB, int g, int tid) {
    const float step = expf(p.s5_log_step[g]);
#pragma unroll 1
    for (int e = tid; e < (LC + 1) * 64; e += 512) { const int d = e >> 6, pp = e & 63;
        const float lre = p.s5_lam_re[g * S5P + pp], lim = p.s5_lam_im[g * S5P + pp];
        const float er = expf((float)d * lre * step); float sn, cs; sincosf((float)d * lim * step, &sn, &cs);
        LPW[e] = (f32x2){er * cs, er * sn}; }
#pragma unroll 1
    for (int e = tid; e < 1024; e += 512) {
        {   const int pp = e >> 4, c = e & 15;
            const float lre = p.s5_lam_re[g * S5P + pp], lim = p.s5_lam_im[g * S5P + pp];
            const float er = expf(lre * step); float sn, cs; sincosf(lim * step, &sn, &cs);
            const float nr = er * cs - 1.f, ni = er * sn, den = lre * lre + lim * lim;
            const float cr = (nr * lre + ni * lim) / den, ci = (ni * lre - nr * lim) / den;
            const float br = p.s5_b_re[((size_t)g * S5P + pp) * 16 + c], bi = p.s5_b_im[((size_t)g * S5P + pp) * 16 + c];
            BB[e] = (f32x2){cr * br - ci * bi, cr * bi + ci * br}; }
        {   const int c = e >> 6, pp = e & 63;
            CC[e] = (f32x2){p.s5_c_re[((size_t)g * 16 + c) * S5P + pp], p.s5_c_im[((size_t)g * 16 + c) * S5P + pp]}; }
    }
    __syncthreads();
}
__device__ __forceinline__ void p0_s5_kt(const P& p, LAS unsigned char* lds, int g, int part, int tid) {
    LAS f32x2* LPW = (LAS f32x2*)lds; LAS f32x2* CC = LPW + (LC + 1) * 64; LAS f32x2* BB = CC + 16 * 64;
    s5_tables(p, LPW, CC, BB, g, tid);
    float* KTG = (float*)(p.ws + WS_KTG) + (size_t)g * LC * 256;
    for (int e = tid; e < 4 * 256; e += 512) { const int d = 4 * part + (e >> 8), c = (e >> 4) & 15, c2 = e & 15; float acc = 0.f;
#pragma unroll 4
        for (int pp = 0; pp < 64; ++pp) { const f32x2 cc = CC[c * 64 + pp], lp = LPW[d * 64 + pp], bb = BB[pp * 16 + c2];
            const float wr_ = cc.x * lp.x - cc.y * lp.y, wi_ = cc.x * lp.y + cc.y * lp.x;
            acc += wr_ * bb.x - wi_ * bb.y; }
        KTG[d * 256 + c * 16 + c2] = acc; }
    __syncthreads();
}
__device__ __forceinline__ void p0_s5_build(const P& p, LAS unsigned char* lds, int g, int part, int tid) {
    LAS f32x2* LPW = (LAS f32x2*)lds;
    LAS f32x2* CC  = LPW + (LC + 1) * 64;
    LAS f32x2* BB  = CC + 16 * 64;
    LAS float* KT  = (LAS float*)(BB + 64 * 16);
    {   const f32x4* KTG = (const f32x4*)((const float*)(p.ws + WS_KTG) + (size_t)g * LC * 256);
        for (int e = tid; e < LC * 64; e += 512) ((LAS f32x4*)KT)[e] = KTG[e]; }
    s5_tables(p, LPW, CC, BB, g, tid);
    const int wave = tid >> 6, lane = tid & 63;
    bf16* BtY = (bf16*)(p.ws + WS_BTY) + (size_t)g * S5KU * S5KT;
    for (int rr = 0; rr < 8; ++rr) {
        const int n = 64 * part + 8 * wave + rr, i = n >> 4, c = n & 15;
        for (int ch = lane; ch < S5KT / 8; ch += 64) {
            const int k0 = 8 * ch; float v[8];
            if (k0 < S5KU) { const int i2 = k0 >> 4, c0 = k0 & 15;
#pragma unroll
                for (int e = 0; e < 8; ++e) v[e] = (i2 <= i) ? KT[((i - i2) * 16 + c) * 16 + c0 + e] : 0.f; }
            else { const int q0 = k0 - S5KU; const bool im = q0 >= 64; const int p0 = q0 & 63;
#pragma unroll
                for (int e = 0; e < 8; ++e) { const f32x2 cc = CC[c * 64 + p0 + e], lp = LPW[(i + 1) * 64 + p0 + e];
                    v[e] = im ? -(cc.x * lp.y + cc.y * lp.x) : (cc.x * lp.x - cc.y * lp.y); } }
            u32x4 o; o.x = cvt_pk_bf16(v[0], v[1]); o.y = cvt_pk_bf16(v[2], v[3]); o.z = cvt_pk_bf16(v[4], v[5]); o.w = cvt_pk_bf16(v[6], v[7]);
            *(GAS u32x4*)(BtY + (size_t)n * S5KT + k0) = o;
        }
    }
    bf16* BtE = (bf16*)(p.ws + WS_BTE) + (size_t)g * 128 * S5KU;
    for (int rr = 0; rr < 2; ++rr) {
        const int r = 16 * part + 2 * wave + rr; const bool im = r >= 64; const int pp = r & 63;
        const int k0 = 8 * lane, i2 = k0 >> 4, c0 = k0 & 15; float v[8];
        const f32x2 lp = LPW[(LC - 1 - i2) * 64 + pp];
#pragma unroll
        for (int e = 0; e < 8; ++e) { const f32x2 bb = BB[pp * 16 + c0 + e]; v[e] = im ? (lp.x * bb.y + lp.y * bb.x) : (lp.x * bb.x - lp.y * bb.y); }
        u32x4 o; o.x = cvt_pk_bf16(v[0], v[1]); o.y = cvt_pk_bf16(v[2], v[3]); o.z = cvt_pk_bf16(v[4], v[5]); o.w = cvt_pk_bf16(v[6], v[7]);
        *(GAS u32x4*)(BtE + (size_t)r * S5KU + k0) = o;
    }
    if (part == 0 && tid < 64) ((f32x2*)(p.ws + WS_LAML))[g * 64 + tid] = LPW[LC * 64 + tid];
    __syncthreads();
}

template <int PASS, bool FUSED = false> __device__ __forceinline__ void lru_pass(const P& p, LAS unsigned char* lds, int G, int bx, int tid, int lane, int wave, int nbusy, int xtra) {
    const int h = bx % LH, q = bx / LH, nblk = (G - h + LH - 1) / LH, nq1 = (nbusy > h) ? ((nbusy - h + LH - 1) / LH < nblk ? (nbusy - h + LH - 1) / LH : nblk) : 0, n2 = nblk - nq1;
    const bool busy = q < nq1; const int R0 = xtra * n2;
#define LRU_TILE(k) (busy ? (R0 + (k) * nblk + q) : ((k) < xtra ? ((k) * n2 + (q - nq1)) : (R0 + ((k) - xtra) * nblk + q)))
    LAS float* RL = (LAS float*)lds; LAS float* IL = RL + 128 * 68;
    LAS bf16* XCB = (LAS bf16*)(lds + 3 * LTT * 128 * 4); LAS f32x2* SEG = (LAS f32x2*)(lds + 3 * LTT * 128 * 4 + LTT * 136 * 2);
    const bf16* XLg = (const bf16*)(p.ws + WS_XL); const bf16* GYg = (const bf16*)(p.ws + WS_GY); bf16* OC = (bf16*)(p.ws + WS_OUTC);
    const int j = tid & 127, s = tid >> 7, ch = h * LHD + j;
    const float cw0 = p.lru_conv_w[0 * LW + ch], cw1 = p.lru_conv_w[1 * LW + ch], cw2 = p.lru_conv_w[2 * LW + ch], cw3 = p.lru_conv_w[3 * LW + ch], cb = p.lru_conv_b[ch];
    const float nba = -1.4426950408889634f * p.lru_b_a[ch], nbx = -1.4426950408889634f * p.lru_b_x[ch];
    const float lam = p.lru_lambda[ch];
    const float sp8 = -8.f * 1.4426950408889634f * ((-lam > 20.f) ? -lam : log1pf(expf(-lam)));
    const int gate = wave >> 2, cb0 = (wave & 3) * 32, fr = lane & 15, fq = lane >> 4;
    const bf16* WL = (const bf16*)(p.ws + WS_WLT) + (size_t)h * 256 * 128;
    bf16x8 Bf[2][4];
#pragma unroll
    for (int nb = 0; nb < 2; ++nb)
#pragma unroll
        for (int ks = 0; ks < 4; ++ks) Bf[nb][ks] = *(const bf16x8*)(WL + (size_t)(gate * 128 + cb0 + 16 * nb + fr) * 128 + ks * 32 + 8 * fq);
    bf16 xs[19], xn[19], gs[16], gn[16]; float hin = 0.f, hinn = 0.f;
    const int kidx = LRU_TILE(0);
    if (kidx < LNT) { const int tb = kidx * LTT + 16 * s;
#pragma unroll
        for (int i = 0; i < 19; ++i) xs[i] = (tb - 3 + i >= 0) ? XLg[(size_t)(tb - 3 + i) * LW + ch] : (bf16)0;
        if (PASS == 1) {
#pragma unroll
            for (int i = 0; i < 16; ++i) gs[i] = __builtin_nontemporal_load(GYg + (size_t)(tb + i) * LW + ch);
            if (!FUSED) hin = ((const float*)(p.ws + WS_HIN))[(size_t)kidx * LW + ch]; } }
    for (int kk = 0; ; ++kk) {
        const int tt = LRU_TILE(kk); if (tt >= LNT) break;
        const int t0 = tt * LTT, tb = t0 + 16 * s; const int tn = LRU_TILE(kk + 1);
        if (FUSED && PASS == 1) {
            const LAS f32x2* PRE = (const LAS f32x2*)(lds + LRU_PRE_OFF); const LAS f32x2* SG4 = (const LAS f32x2*)(lds + LRU_SG4_OFF);
            const f32x2 pr = PRE[kk * 128 + j]; const int qd = tt >> 6; float c = 0.f;
#pragma unroll
            for (int d = 0; d < 3; ++d) { const f32x2 sg = SG4[d * 128 + j]; if (d < qd) c = sg.x * c + sg.y; }
            hin = pr.x * c + pr.y; }
        float xcv[16];
        {
            float x0 = bf2f(xs[0]), x1 = bf2f(xs[1]), x2 = bf2f(xs[2]);
#pragma unroll
            for (int i = 0; i < 16; ++i) { const float x3 = bf2f(xs[3 + i]);
                const float xc = cb + cw0 * x0 + cw1 * x1 + cw2 * x2 + cw3 * x3; x0 = x1; x1 = x2; x2 = x3;
                xcv[i] = xc; XCB[(16 * s + i) * 136 + j] = (bf16)cvt_pk_bf16(xc, xc); }
        }
        if (tn < LNT) { const int tbn = tn * LTT + 16 * s;
#pragma unroll
            for (int i = 0; i < 19; ++i) xn[i] = XLg[(size_t)(tbn - 3 + i) * LW + ch];
            if (PASS == 1) {
#pragma unroll
                for (int i = 0; i < 16; ++i) gn[i] = __builtin_nontemporal_load(GYg + (size_t)(tbn + i) * LW + ch);
                if (!FUSED) hinn = ((const float*)(p.ws + WS_HIN))[(size_t)tn * LW + ch]; } }
        __syncthreads();
        {
            f32x4 acc[4][2];
#pragma unroll
            for (int mb = 0; mb < 4; ++mb) { acc[mb][0] = (f32x4){0.f, 0.f, 0.f, 0.f}; acc[mb][1] = (f32x4){0.f, 0.f, 0.f, 0.f}; }
#pragma unroll
            for (int mb = 0; mb < 4; ++mb)
#pragma unroll
                for (int ks = 0; ks < 4; ++ks) { const bf16x8 a = *(const LAS bf16x8*)(XCB + (16 * mb + fr) * 136 + ks * 32 + 8 * fq);
                    acc[mb][0] = __builtin_amdgcn_mfma_f32_16x16x32_bf16(a, Bf[0][ks], acc[mb][0], 0, 0, 0);
                    acc[mb][1] = __builtin_amdgcn_mfma_f32_16x16x32_bf16(a, Bf[1][ks], acc[mb][1], 0, 0, 0); }
            LAS float* OL = gate ? IL : RL;
#pragma unroll
            for (int mb = 0; mb < 4; ++mb)
#pragma unroll
                for (int nb = 0; nb < 2; ++nb) *(LAS f32x4*)(OL + (cb0 + 16 * nb + fr) * 68 + 16 * mb + 4 * fq) = acc[mb][nb];
        }
        __syncthreads();
        float av[16], bv[16]; float Ap = 1.f, Hp = 0.f;
        float zr[16], zi[16];
#pragma unroll
        for (int q = 0; q < 4; ++q) { const f32x4 a4 = *(const LAS f32x4*)(RL + j * 68 + 16 * s + 4 * q), b4 = *(const LAS f32x4*)(IL + j * 68 + 16 * s + 4 * q);
            zr[4 * q] = a4[0]; zr[4 * q + 1] = a4[1]; zr[4 * q + 2] = a4[2]; zr[4 * q + 3] = a4[3]; zi[4 * q] = b4[0]; zi[4 * q + 1] = b4[1]; zi[4 * q + 2] = b4[2]; zi[4 * q + 3] = b4[3]; }
        asm volatile("s_waitcnt lgkmcnt(0)" ::: "memory");
#pragma unroll
        for (int i = 0; i < 16; ++i) {
            const float r = __builtin_amdgcn_rcpf(1.f + __builtin_amdgcn_exp2f(__builtin_fmaf(zr[i], -1.4426950408889634f, nba)));
            const float ig = __builtin_amdgcn_rcpf(1.f + __builtin_amdgcn_exp2f(__builtin_fmaf(zi[i], -1.4426950408889634f, nbx)));
            const float a = __builtin_amdgcn_exp2f(sp8 * r);
            float mult = __builtin_amdgcn_sqrtf(__builtin_fmaf(-a, a, 1.f));
            if (i == 0) mult = (t0 + 16 * s == 0) ? 1.f : mult;
            const float bb = xcv[i] * ig * mult;
            av[i] = a; bv[i] = bb; Hp = a * Hp + bb; Ap *= a; }
        SEG[s * 128 + j] = (f32x2){Ap, Hp};
        __syncthreads();
        if (PASS == 0) {
            if (s == 0) { float A = 1.f, H = 0.f;
#pragma unroll
                for (int q = 0; q < 4; ++q) { const f32x2 sg = SEG[q * 128 + j]; H = sg.x * H + sg.y; A *= sg.x; }
                if (FUSED) __hip_atomic_store((unsigned long long*)(p.ws + WS_AG) + (size_t)tt * LW + ch, __builtin_bit_cast(unsigned long long, (f32x2){A, H}), __ATOMIC_RELAXED, __HIP_MEMORY_SCOPE_AGENT);
                else ((f32x2*)(p.ws + WS_AG))[(size_t)tt * LW + ch] = (f32x2){A, H}; }
        } else {
            float hc = hin;
#pragma unroll
            for (int q = 0; q < 3; ++q) { const f32x2 sg = SEG[q * 128 + j]; if (q < s) hc = sg.x * hc + sg.y; }
#pragma unroll
            for (int i = 0; i < 16; ++i) { hc = av[i] * hc + bv[i]; ((unsigned char*)OC)[(size_t)(tb + i) * D + S5W + ch] = (unsigned char)F8PK(hc * bf2f(gs[i]) * 16.f, 0.f, 0u, false); }
        }
#pragma unroll
        for (int i = 0; i < 19; ++i) xs[i] = xn[i];
        if (PASS == 1) {
#pragma unroll
            for (int i = 0; i < 16; ++i) gs[i] = gn[i];
            if (!FUSED) hin = hinn; }
    }
    __syncthreads();
#undef LRU_TILE
}

constexpr int CW_LH = 32768;
__device__ __forceinline__ void lru_mid(const P& p, LAS unsigned char* lds, unsigned* ctl, int li, int GL, int bl, int tid) {
    const int h = bl % LH, q = bl / LH, nblk = (GL - h + LH - 1) / LH;
    const int j = tid & 127, s = tid >> 7, ch = h * LHD + j;
    unsigned* cnt = ctl + CW_LH + li * 1024 + 64 * h;
    asm volatile("s_waitcnt vmcnt(0)" ::: "memory");
    if ((tid & 63) == 0) __hip_atomic_fetch_add(cnt, 1u, __ATOMIC_RELAXED, __HIP_MEMORY_SCOPE_AGENT);
    if (tid < 64) { unsigned sp = 0; const int want = nblk * NWAVES;
        while ((int)__builtin_amdgcn_readfirstlane(__hip_atomic_load(cnt, __ATOMIC_RELAXED, __HIP_MEMORY_SCOPE_AGENT)) < want) { __builtin_amdgcn_s_sleep(2); if (++sp > (1u << 22)) break; }
        __builtin_amdgcn_fence(__ATOMIC_ACQUIRE, "agent");
        asm volatile("s_waitcnt vmcnt(0)" ::: "memory"); }
    __syncthreads();
    LAS f32x2* PRE = (LAS f32x2*)(lds + LRU_PRE_OFF); LAS f32x2* SG4 = (LAS f32x2*)(lds + LRU_SG4_OFF);
    const f32x2* AGh = (const f32x2*)(p.ws + WS_AG) + (size_t)(64 * s) * LW + ch;
    int k = (64 * s <= q) ? 0 : (64 * s - q + nblk - 1) / nblk; int nxt = q + k * nblk - 64 * s;
    float A = 1.f, H = 0.f; f32x2 va[16], vb[16];
#pragma unroll
    for (int i = 0; i < 16; ++i) va[i] = AGh[(size_t)i * LW];
#pragma unroll
    for (int i = 0; i < 16; ++i) vb[i] = AGh[(size_t)(16 + i) * LW];
#pragma unroll
    for (int i = 0; i < 16; ++i) { if (i == nxt) { PRE[k * 128 + j] = (f32x2){A, H}; ++k; nxt += nblk; } H = va[i].x * H + va[i].y; A *= va[i].x; }
#pragma unroll
    for (int i = 0; i < 16; ++i) va[i] = AGh[(size_t)(32 + i) * LW];
#pragma unroll
    for (int i = 0; i < 16; ++i) { if (16 + i == nxt) { PRE[k * 128 + j] = (f32x2){A, H}; ++k; nxt += nblk; } H = vb[i].x * H + vb[i].y; A *= vb[i].x; }
#pragma unroll
    for (int i = 0; i < 16; ++i) vb[i] = AGh[(size_t)(48 + i) * LW];
#pragma unroll
    for (int i = 0; i < 16; ++i) { if (32 + i == nxt) { PRE[k * 128 + j] = (f32x2){A, H}; ++k; nxt += nblk; } H = va[i].x * H + va[i].y; A *= va[i].x; }
#pragma unroll
    for (int i = 0; i < 16; ++i) { if (48 + i == nxt) { PRE[k * 128 + j] = (f32x2){A, H}; ++k; nxt += nblk; } H = vb[i].x * H + vb[i].y; A *= vb[i].x; }
    SG4[s * 128 + j] = (f32x2){A, H};
    __syncthreads();
}

__device__ __forceinline__ void scan_lru(const P& p, int w, int lane) {
    const int ch = 64 * w + lane; const f32x2* AG = (const f32x2*)(p.ws + WS_AG); float* HIN = (float*)(p.ws + WS_HIN);
    float hc = 0.f; f32x2 a[8], b[8];
#pragma unroll
    for (int q = 0; q < 8; ++q) a[q] = AG[(size_t)q * LW + ch];
    for (int tt = 0; tt < LNT; tt += 16) {
#pragma unroll
        for (int q = 0; q < 8; ++q) b[q] = AG[(size_t)(tt + 8 + q) * LW + ch];
#pragma unroll
        for (int q = 0; q < 8; ++q) { HIN[(size_t)(tt + q) * LW + ch] = hc; hc = a[q].x * hc + a[q].y; }
        if (tt + 16 < LNT) {
#pragma unroll
            for (int q = 0; q < 8; ++q) a[q] = AG[(size_t)(tt + 16 + q) * LW + ch]; }
#pragma unroll
        for (int q = 0; q < 8; ++q) { HIN[(size_t)(tt + 8 + q) * LW + ch] = hc; hc = b[q].x * hc + b[q].y; }
    }
}
__device__ __forceinline__ void scan_s5(const P& p, int g, int lane) {
    const f32x2 lam = ((const f32x2*)(p.ws + WS_LAML))[g * 64 + lane];
    const float* SE = (const float*)(p.ws + WS_SEND) + (size_t)g * NCH * 128; bf16* UX = (bf16*)(p.ws + WS_U5X) + (size_t)g * NCH * S5KT;
    float sr = 0.f, si = 0.f; float er[8], ei[8], fr_[8], fi_[8];
#pragma unroll
    for (int q = 0; q < 8; ++q) { er[q] = SE[(size_t)q * 128 + lane]; ei[q] = SE[(size_t)q * 128 + 64 + lane]; }
    for (int jc = 0; jc < NCH; jc += 16) {
#pragma unroll
        for (int q = 0; q < 8; ++q) { fr_[q] = SE[(size_t)(jc + 8 + q) * 128 + lane]; fi_[q] = SE[(size_t)(jc + 8 + q) * 128 + 64 + lane]; }
#pragma unroll
        for (int q = 0; q < 8; ++q) { UX[(size_t)(jc + q) * S5KT + S5KU + lane] = f2bf(sr); UX[(size_t)(jc + q) * S5KT + S5KU + 64 + lane] = f2bf(si);
            const float nr = lam.x * sr - lam.y * si + er[q], ni = lam.x * si + lam.y * sr + ei[q]; sr = nr; si = ni; }
        if (jc + 16 < NCH) {
#pragma unroll
            for (int q = 0; q < 8; ++q) { er[q] = SE[(size_t)(jc + 16 + q) * 128 + lane]; ei[q] = SE[(size_t)(jc + 16 + q) * 128 + 64 + lane]; } }
#pragma unroll
        for (int q = 0; q < 8; ++q) { UX[(size_t)(jc + 8 + q) * S5KT + S5KU + lane] = f2bf(sr); UX[(size_t)(jc + 8 + q) * S5KT + S5KU + 64 + lane] = f2bf(si);
            const float nr = lam.x * sr - lam.y * si + fr_[q], ni = lam.x * si + lam.y * sr + fi_[q]; sr = nr; si = ni; }
    }
}


__device__ __forceinline__ void scan_s5_par(const P& p, LAS unsigned char* lds, int g, int lane, int wave) {
    const f32x2 lam = ((const f32x2*)(p.ws + WS_LAML))[g * 64 + lane];
    const float* SE = (const float*)(p.ws + WS_SEND) + ((size_t)g * NCH + 64 * wave) * 128; bf16* UX = (bf16*)(p.ws + WS_U5X) + ((size_t)g * NCH + 64 * wave) * S5KT;
    LAS f32x2* ZL = (LAS f32x2*)lds;
    float sr = 0.f, si = 0.f; float er[8], ei[8], fr_[8], fi_[8];
#pragma unroll
    for (int q = 0; q < 8; ++q) { er[q] = SE[(size_t)q * 128 + lane]; ei[q] = SE[(size_t)q * 128 + 64 + lane]; }
#pragma unroll 1
    for (int jc = 0; jc < 64; jc += 16) {
#pragma unroll
        for (int q = 0; q < 8; ++q) { fr_[q] = SE[(size_t)(jc + 8 + q) * 128 + lane]; fi_[q] = SE[(size_t)(jc + 8 + q) * 128 + 64 + lane]; }
#pragma unroll
        for (int q = 0; q < 8; ++q) { const float nr = lam.x * sr - lam.y * si + er[q], ni = lam.x * si + lam.y * sr + ei[q]; sr = nr; si = ni; }
        {   const int jn = (jc + 16 < 64) ? jc + 16 : 0;
#pragma unroll
            for (int q = 0; q < 8; ++q) { er[q] = SE[(size_t)(jn + q) * 128 + lane]; ei[q] = SE[(size_t)(jn + q) * 128 + 64 + lane]; } }
#pragma unroll
        for (int q = 0; q < 8; ++q) { const float nr = lam.x * sr - lam.y * si + fr_[q], ni = lam.x * si + lam.y * sr + fi_[q]; sr = nr; si = ni; }
    }
    ZL[wave * 64 + lane] = (f32x2){sr, si};
    float pr = lam.x, pi = lam.y;
#pragma unroll
    for (int q = 0; q < 6; ++q) { const float nr = pr * pr - pi * pi, ni = 2.f * pr * pi; pr = nr; pi = ni; }
    __syncthreads();
    sr = 0.f; si = 0.f;
    for (int w = 0; w < wave; ++w) { const f32x2 z = ZL[w * 64 + lane]; const float nr = pr * sr - pi * si + z.x, ni = pr * si + pi * sr + z.y; sr = nr; si = ni; }
#pragma unroll 1
    for (int jc = 0; jc < 64; jc += 16) {
#pragma unroll
        for (int q = 0; q < 8; ++q) { fr_[q] = SE[(size_t)(jc + 8 + q) * 128 + lane]; fi_[q] = SE[(size_t)(jc + 8 + q) * 128 + 64 + lane]; }
#pragma unroll
        for (int q = 0; q < 8; ++q) { UX[(size_t)(jc + q) * S5KT + S5KU + lane] = f2bf(sr); UX[(size_t)(jc + q) * S5KT + S5KU + 64 + lane] = f2bf(si);
            const float nr = lam.x * sr - lam.y * si + er[q], ni = lam.x * si + lam.y * sr + ei[q]; sr = nr; si = ni; }
        if (jc + 16 < 64) {
#pragma unroll
            for (int q = 0; q < 8; ++q) { er[q] = SE[(size_t)(jc + 16 + q) * 128 + lane]; ei[q] = SE[(size_t)(jc + 16 + q) * 128 + 64 + lane]; } }
#pragma unroll
        for (int q = 0; q < 8; ++q) { UX[(size_t)(jc + 8 + q) * S5KT + S5KU + lane] = f2bf(sr); UX[(size_t)(jc + 8 + q) * S5KT + S5KU + 64 + lane] = f2bf(si);
            const float nr = lam.x * sr - lam.y * si + fr_[q], ni = lam.x * si + lam.y * sr + fi_[q]; sr = nr; si = ni; }
    }
}

constexpr int CW_ECNT = 16384;
constexpr int ECNT_OFF = MISC_OFF + 128;
__device__ __forceinline__ void router_phase(const P& p, LAS unsigned char* lds, int G, int bx, int tid, int lane, int wave, bool dry) {
    LAS float* PL = (LAS float*)lds;
    LAS unsigned* HC = (LAS unsigned*)(lds + 8 * 32 * 40 * 4);
    const float* WR = (const float*)(p.ws + WS_WR); const float* WG = (const float*)(p.ws + WS_WG);
    unsigned* gcount = (unsigned*)(p.ws + WS_CTL) + CW_ECNT;
    int* LISTI = (int*)(p.ws + WS_LISTI); float* LISTR = (float*)(p.ws + WS_LISTR); float* LISTW = (float*)(p.ws + WS_LISTW);
    const int tt = wave >> 2, kq = wave & 3, i = lane & 31, kh = lane >> 5;
    LAS f32x4* WGL = (LAS f32x4*)(lds + 49152);
    for (int e = tid; e < D; e += NWAVES * 64) WGL[e] = ((const f32x4*)WG)[e];
    __syncthreads();
#define RT_LOAD(X, BW, it_) do { X[0] = *(const u32x4*)(dl + (it_) * 32); X[1] = *(const u32x4*)(dl + (it_) * 32 + 8); \
        _Pragma("unroll") for (int q = 0; q < 16; ++q) BW[q] = wrp[(size_t)((it_) * 32 + q) * 32]; } while (0)
#define RT_STEP(XW, BW, it_) do { f32x4 X[4]; unpack8(XW[0], X[0], X[1]); unpack8(XW[1], X[2], X[3]); \
        { u32x4 w0; \
          { unsigned w_ = 0; w_ = F8PK(X[0][0], X[0][1], w_, false); w_ = F8PK(X[0][2], X[0][3], w_, true); w0.x = w_; } \
          { unsigned w_ = 0; w_ = F8PK(X[1][0], X[1][1], w_, false); w_ = F8PK(X[1][2], X[1][3], w_, true); w0.y = w_; } \
          { unsigned w_ = 0; w_ = F8PK(X[2][0], X[2][1], w_, false); w_ = F8PK(X[2][2], X[2][3], w_, true); w0.z = w_; } \
          { unsigned w_ = 0; w_ = F8PK(X[3][0], X[3][1], w_, false); w_ = F8PK(X[3][2], X[3][3], w_, true); w0.w = w_; } \
          if (!dry) *(u32x4*)(xb + (it_) * 32) = w0; } \
        _Pragma("unroll") for (int g4 = 0; g4 < 4; ++g4) _Pragma("unroll") for (int q = 0; q < 4; ++q) { const float xv = X[g4][q]; \
            acc = __builtin_amdgcn_mfma_f32_32x32x2f32(xv, BW[4 * g4 + q], acc, 0, 0, 0); ga += WGL[kq * 512 + (it_) * 32 + 16 * kh + 4 * g4 + q] * xv; ss += xv * xv; } } while (0)
    for (int tg = bx; tg < T / 64; tg += G) {
        if (tid < 32) HC[tid] = 0u;
        const size_t xoff = (size_t)(tg * 64 + tt * 32 + i) * D + kq * 512 + 16 * kh;
        const bf16* dl = (const bf16*)(p.ws + WS_DELTA) + xoff; unsigned char* xb = (unsigned char*)(p.ws + WS_X1B) + xoff;
        const float* wrp = WR + (size_t)(kq * 512 + 16 * kh) * 32 + i;
        f32x16 acc;
#pragma unroll
        for (int r = 0; r < 16; ++r) acc[r] = 0.f;
        f32x4 ga = (f32x4){0.f, 0.f, 0.f, 0.f}; float ss = 0.f;
        u32x4 xA[2], xB[2]; float bA[16], bB[16];
        RT_LOAD(xA, bA, 0);
#pragma unroll 1
        for (int it = 0; it < 16; it += 2) {
            RT_LOAD(xB, bB, it + 1);
            RT_STEP(xA, bA, it);
            if (it + 2 < 16) RT_LOAD(xA, bA, it + 2);
            RT_STEP(xB, bB, it + 1);
        }
#undef RT_LOAD
#undef RT_STEP
#pragma unroll
        for (int q = 0; q < 4; ++q) ga[q] += __shfl_xor(ga[q], 32);
        ss += __shfl_xor(ss, 32);
        LAS float* pw = PL + wave * 32 * 40;
#pragma unroll
        for (int r = 0; r < 16; ++r) pw[((r & 3) + 8 * (r >> 2) + 4 * kh) * 40 + 4 + i] = acc[r];
        if (kh == 0) { pw[i * 40 + 0] = ga[0]; pw[i * 40 + 1] = ga[1]; pw[i * 40 + 2] = ga[2]; pw[i * 40 + 3] = ga[3]; pw[i * 40 + 36] = ss; }
        __syncthreads();
        if (tid < 64) {
            const LAS float* q0 = PL + ((tid >> 5) * 4) * 32 * 40 + (tid & 31) * 40;
            float lg[37];
#pragma unroll
            for (int q = 0; q < 37; ++q) lg[q] = (q0[q] + q0[32 * 40 + q]) + (q0[2 * 32 * 40 + q] + q0[3 * 32 * 40 + q]);
            const float rstd = rsqrtf(lg[36] * (1.f / D) + EPS);
            float gmax = lg[0] * rstd + p.b_rg[0]; int gi = 0;
#pragma unroll
            for (int q = 1; q < 4; ++q) { const float v = lg[q] * rstd + p.b_rg[q]; if (v > gmax) { gmax = v; gi = q; } }
            float gs = 0.f;
#pragma unroll
            for (int q = 0; q < 4; ++q) gs += __expf(lg[q] * rstd + p.b_rg[q] - gmax);
            const float gtop = 1.f / gs;
            float m1 = -INFINITY, m2 = -INFINITY; int i1 = 0, i2 = 0;
#pragma unroll
            for (int e = 0; e < 32; ++e) { const float v = lg[4 + e] * rstd + p.b_re[e];
                if ((e >> 3) == gi) { if (v > m1) { m2 = m1; i2 = i1; m1 = v; i1 = e; } else if (v > m2) { m2 = v; i2 = e; } } }
            const float e2 = __expf(m2 - m1);
            const float w1 = gtop / (1.f + e2), w2 = gtop * e2 / (1.f + e2);
            if (!dry) {
            const unsigned r1 = atomicAdd((unsigned*)&HC[i1], 1u), r2 = atomicAdd((unsigned*)&HC[i2], 1u);
            asm volatile("s_waitcnt lgkmcnt(0)" ::: "memory");
            if (tid < 32) { const unsigned c = HC[tid]; HC[32 + tid] = c ? atomicAdd(&gcount[tid], c) : 0u; }
            asm volatile("s_waitcnt vmcnt(0) lgkmcnt(0)" ::: "memory");
            const unsigned s1 = HC[32 + i1] + r1, s2 = HC[32 + i2] + r2; const int tok = tg * 64 + tid;
            LISTI[(size_t)i1 * T + s1] = tok * 2;     LISTR[(size_t)i1 * T + s1] = rstd; LISTW[(size_t)i1 * T + s1] = w1;
            LISTI[(size_t)i2 * T + s2] = tok * 2 + 1; LISTR[(size_t)i2 * T + s2] = rstd; LISTW[(size_t)i2 * T + s2] = w2;
            } else if (w1 + w2 == 12345.f) LISTW[0] = w1;
        }
        __syncthreads();
    }
}
template <int NPN> __device__ __forceinline__ bool moe_find(const LAS unsigned* ecnt, int L, pg8::Unit& u) {
    int e = 0, tp = 0, cnt = 0, found = 0;
    for (int q = 0; q < NE; ++q) { const int c = (int)ecnt[q], n = ((c + 255) >> 8) * NPN; if (!found) { if (L < n) { found = 1; e = q; cnt = c; } else { L -= n; tp += (c + 255) >> 8; } } }
    if (!__builtin_amdgcn_readfirstlane(found)) return false;
    u.aux = __builtin_amdgcn_readfirstlane(e); u.aux2 = __builtin_amdgcn_readfirstlane(tp) * 256; u.aux3 = __builtin_amdgcn_readfirstlane(cnt);
    const int Lr = __builtin_amdgcn_readfirstlane(L); u.pm = Lr / NPN; u.pn = Lr % NPN; return true;
}
constexpr int CW_M9 = 16512;
struct MoeOrder1 {
    static constexpr bool GATHER = true;
    int G, c; const LAS unsigned* ecnt; const char* X1B; const char* W; const int* LISTI; unsigned* ctl; bool count;
    __device__ bool next(int i, pg8::Unit& u) const {
        if (!moe_find<2>(ecnt, i * G + c, u)) return false;
        u.A = X1B; u.B = W + ((size_t)u.aux * 512 + 256 * u.pn) * D; u.nt = D / 128; u.unit_i = i; return true; }
    __device__ __forceinline__ void a_offsets(const pg8::Unit& u, const int (&Ra)[2], const int (&Ca)[2], unsigned (&voff)[2][2]) const {
#pragma unroll
        for (int hh = 0; hh < 2; ++hh)
#pragma unroll
            for (int i = 0; i < 2; ++i) { int idx = u.pm * 256 + hh * 128 + Ra[i]; idx = idx < u.aux3 ? idx : 0;
                voff[hh][i] = (unsigned)(LISTI[(size_t)u.aux * T + idx] >> 1) * (unsigned)D + (unsigned)Ca[i]; }
    }
    __device__ __forceinline__ void a_ready(const pg8::Unit&) const {}
    __device__ __forceinline__ void done(const pg8::Unit& u) const {
        asm volatile("s_waitcnt vmcnt(0)" ::: "memory");
        if (count && (threadIdx.x & 63) == 0) __hip_atomic_fetch_add(ctl + CW_M9 + 64 * u.unit_i, 1u, __ATOMIC_RELAXED, __HIP_MEMORY_SCOPE_AGENT);
    }
};
struct EpiMoe1 {
    static constexpr bool PERM = true; static constexpr bool KEEP = false;
    const float* LISTR; const float* LISTW; bf16* ACT;
    __device__ __forceinline__ void operator()(const f32x4 (&acc)[2][2][4][2], const pg8::Unit& u, int wr, int wc, int fr, int fq) const {
        const int e = u.aux, cnt = u.aux3;
        float rsv[2][4], wv[2][4];
#pragma unroll
        for (int ai = 0; ai < 2; ++ai)
#pragma unroll
            for (int m = 0; m < 4; ++m) { const int idx = u.pm * 256 + ai * 128 + wr * 64 + m * 16 + fr; const bool valid = idx < cnt;
                rsv[ai][m] = valid ? LISTR[(size_t)e * T + idx] : 0.f; wv[ai][m] = valid ? LISTW[(size_t)e * T + idx] : 0.f; }
#pragma unroll
        for (int ai = 0; ai < 2; ++ai)
#pragma unroll
            for (int m = 0; m < 4; ++m) { const int idx = u.pm * 256 + ai * 128 + wr * 64 + m * 16 + fr; const bool valid = idx < cnt;
                const float rs = rsv[ai][m] * (1.f / 64.f), w = wv[ai][m];
                f32x4 a0, a1;
#pragma unroll
                for (int q = 0; q < 4; ++q) { const float g0 = acc[ai][0][m][0][q] * rs, g1 = acc[ai][0][m][1][q] * rs;
                    a0[q] = g0 * fsig(g0) * (acc[ai][1][m][0][q] * rs) * w; a1[q] = g1 * fsig(g1) * (acc[ai][1][m][1][q] * rs) * w; }
                u32x4 o; o.x = cvt_pk_bf16(a0[0], a0[1]); o.y = cvt_pk_bf16(a0[2], a0[3]); o.z = cvt_pk_bf16(a1[0], a1[1]); o.w = cvt_pk_bf16(a1[2], a1[3]);
                if (valid) { bf16* dp = ACT + (size_t)(u.aux2 + idx) * EFF + u.pn * 128 + wc * 32 + 8 * fq;
                    asm volatile("global_store_dwordx4 %0, %1, off sc1\n\ts_nop 1" :: "v"(dp), "v"(o) : "memory"); } }
    }
};
struct MoeOrder2 {
    static constexpr bool GATHER = false;
    const LAS unsigned* ecnt; const char* ACT; const char* W; int u0, ustep, ulim, imax;
    __device__ bool next(int i, pg8::Unit& u) const {
        const int L = u0 + i * ustep;
        if (i >= imax || L >= ulim || !moe_find<8>(ecnt, L, u)) return false;
        u.A = ACT + (size_t)(u.aux2 + 256 * u.pm) * EFF * 2; u.B = W + ((size_t)u.aux * D + 256 * u.pn) * EFF * 2; u.nt = EFF / 64; u.unit_i = i; return true; }
    __device__ __forceinline__ void a_offsets(const pg8::Unit&, const int (&)[2], const int (&)[2], unsigned (&)[2][2]) const {}
    __device__ __forceinline__ void a_ready(const pg8::Unit&) const {}
    __device__ __forceinline__ void done(const pg8::Unit&) const {}
};
__device__ __forceinline__ void moe_wait_round(unsigned* ctl, int r, int want) {
    if (threadIdx.x < 64) { unsigned sp = 0;
        while ((int)__builtin_amdgcn_readfirstlane(__hip_atomic_load(ctl + CW_M9 + 64 * r, __ATOMIC_RELAXED, __HIP_MEMORY_SCOPE_AGENT)) < want) { __builtin_amdgcn_s_sleep(2); if (++sp > (1u << 22)) break; }
        __builtin_amdgcn_fence(__ATOMIC_ACQUIRE, "agent");
        asm volatile("s_waitcnt vmcnt(0)" ::: "memory");
    }
    __syncthreads();
}
struct EpiMoe2 {
    static constexpr bool PERM = true; static constexpr bool KEEP = false;
    const int* LISTI; bf16* YS;
    __device__ __forceinline__ void operator()(const f32x4 (&acc)[2][2][4][2], const pg8::Unit& u, int wr, int wc, int fr, int fq) const {
        const int e = u.aux, cnt = u.aux3;
        const int odd = fq & 1;
        int ent[2][2];
#pragma unroll
        for (int ai = 0; ai < 2; ++ai)
#pragma unroll
            for (int pr = 0; pr < 2; ++pr) { const int idx = u.pm * 256 + ai * 128 + wr * 64 + (2 * pr + odd) * 16 + fr; ent[ai][pr] = (idx < cnt) ? LISTI[(size_t)e * T + idx] : -1; }
#pragma unroll
        for (int ai = 0; ai < 2; ++ai)
#pragma unroll
            for (int mp = 0; mp < 4; mp += 2) { const int en = ent[ai][mp >> 1];
#pragma unroll
                for (int bj = 0; bj < 2; ++bj) {
                    const u32x2 oa = pk8_e4m3(acc[ai][bj][mp][0] * 64.f, acc[ai][bj][mp][1] * 64.f), ob = pk8_e4m3(acc[ai][bj][mp + 1][0] * 64.f, acc[ai][bj][mp + 1][1] * 64.f);
                    const u32x4 q = pair16(oa, ob);
                    if (en >= 0) *(u32x4*)((unsigned char*)YS + (size_t)en * D + u.pn * 256 + bj * 128 + wc * 32 + 8 * fq - 8 * odd) = q; } }
    }
};

__global__ void __launch_bounds__(NWAVES * 64, 2) mk_fwd(Args args) {
    extern __shared__ __attribute__((aligned(16))) unsigned char lds_raw[];
    LAS unsigned char* lds = (LAS unsigned char*)lds_raw;
    volatile LAS unsigned* MISC = (volatile LAS unsigned*)(lds + MISC_OFF);
    const P& p = args.p;
    const int tid = threadIdx.x, lane = tid & 63, wave = __builtin_amdgcn_readfirstlane(tid >> 6);
    const int G = gridDim.x; const int bx = blockIdx.x; const int vcu = (G % 8 == 0) ? (bx % 8) * (G / 8) + bx / 8 : bx;
    unsigned char* ws = p.ws;
    unsigned* ctl = (unsigned*)(ws + WS_CTL);
    for (int u = tid; u < (LDS_BYTES - LDSCTL_OFF) / 4; u += NWAVES * 64) ((LAS unsigned*)(lds + LDSCTL_OFF))[u] = 0u;
    __syncthreads();
    if (tid == 0) { unsigned long long pc_; unsigned len_;
        asm volatile("s_getpc_b64 %0\n.Lmk_code_start:\n\ts_mov_b32 %1, .Lmk_code_end - .Lmk_code_start" : "=s"(pc_), "=s"(len_));
        MISC[16] = (unsigned)pc_; MISC[17] = (unsigned)(pc_ >> 32); MISC[18] = len_; }
    __syncthreads();
#define CODE_PF() do { const unsigned long long pc_ = ((unsigned long long)MISC[17] << 32) | MISC[16]; const unsigned len_ = MISC[18]; \
        const unsigned sl_ = ((len_ >> 5) + 8191u) & ~8191u; const unsigned o0_ = (unsigned)((bx >> 3) & 31) * sl_ + (unsigned)tid * 16u; u32x4 t0_, t1_; \
        const char* a0_ = (const char*)pc_ + ((o0_ + 16u <= len_) ? o0_ : 0u); const char* a1_ = (const char*)pc_ + ((o0_ + 8192u + 16u <= len_ && sl_ > 8192u) ? o0_ + 8192u : 0u); \
        asm volatile("global_load_dwordx4 %0, %2, off\n\tglobal_load_dwordx4 %1, %3, off\n\ts_waitcnt vmcnt(0)" : "=&v"(t0_), "=&v"(t1_) : "v"(a0_), "v"(a1_) : "memory"); } while (0)
    {
        const unsigned long long pc_ = ((unsigned long long)MISC[17] << 32) | MISC[16]; const unsigned len_ = MISC[18];
        const unsigned sl_ = ((len_ >> 5) + 8191u) & ~8191u; const unsigned o0_ = (unsigned)((bx >> 3) & 31) * sl_ + (unsigned)tid * 16u;
        const char* a0_ = (const char*)pc_ + ((o0_ + 16u <= len_) ? o0_ : 0u); const char* a1_ = (const char*)pc_ + ((o0_ + 8192u + 16u <= len_ && sl_ > 8192u) ? o0_ + 8192u : 0u);
        __builtin_amdgcn_global_load_lds((const unsigned*)a0_, (LAS unsigned*)(lds + LRU_PRE_OFF + wave * 1024), 16, 0, 0);
        __builtin_amdgcn_global_load_lds((const unsigned*)a1_, (LAS unsigned*)(lds + LRU_PRE_OFF + wave * 1024), 16, 0, 0); }
    XcdBarrier bar = xcd_barrier_post(ctl + CW_BAR + args.li * XCD_BAR_WORDS, MISC + 8);
    const int lo = args.ph_lo, hi = args.ph_hi;
#define IN(k) (lo <= (k) && (k) < hi)
#define BOTH(k) (IN(k) && IN((k) + 1))
#define GRID_BAR() xcd_barrier<true>(bar, ((unsigned long long)MISC[17] << 32) | MISC[16], MISC[18], (unsigned)((bx >> 3) & 31))
    const int gw = vcu * NWAVES + wave, NGW = G * NWAVES;

    if (IN(0)) {
        LAS float* scr = (LAS float*)(lds + RING_OFF + wave * 16384);
        bf16* XB = (bf16*)(ws + WS_XB); unsigned* XF8 = (unsigned*)(ws + WS_XF8); float* rstd1 = (float*)(ws + WS_RSTD1);
        {
            f32x4 va[8], vb[8];
            int m = gw;
            if (m < T && !(args.pad & 8)) { x_ldrow(p.x, m, lane, va);
                for (;;) { const bool hb = m + NGW < T; if (hb) x_ldrow(p.x, m + NGW, lane, vb); x_strow(XB, XF8, rstd1, m, lane, va); if (!hb) break; m += NGW;
                           const bool ha = m + NGW < T; if (ha) x_ldrow(p.x, m + NGW, lane, va); x_strow(XB, XF8, rstd1, m, lane, vb); if (!ha) break; m += NGW; } }
        }
        t_run<0>(p, gw, NGW, lane, scr); t_run<8>(p, gw, NGW, lane, scr);
        t_run<1>(p, gw, NGW, lane, scr); t_run<2>(p, gw, NGW, lane, scr); t_run<3>(p, gw, NGW, lane, scr); t_run<4>(p, gw, NGW, lane, scr);
        if (!(args.pad & 4)) { t_run<7>(p, gw, NGW, lane, scr); t_run<5>(p, gw, NGW, lane, scr, 0, 8192); t_run<6>(p, gw, NGW, lane, scr, 0, 2048); }
        {
            float* WR = (float*)(ws + WS_WR); float* WG = (float*)(ws + WS_WG);
            for (int e = gw * 64 + lane; e < D * 36; e += NGW * 64) { if (e < D * 32) WR[e] = p.norm_ffn_w[e >> 5] * p.w_re[e]; else { const int q = e - D * 32; WG[q] = p.norm_ffn_w[q >> 2] * p.w_rg[q]; } }
        }
        __syncthreads();
        for (int it = vcu; it < S5G * 8; it += G) p0_s5_kt(p, lds + RING_OFF, it >> 3, it & 7, tid);
        if (BOTH(0)) GRID_BAR();
    }
    if (IN(1)) {
        EpiInproj E{(const float*)(ws + WS_RSTD1), p.b_gate, (bf16*)(ws + WS_U5X), (bf16*)(ws + WS_XL), (bf16*)(ws + WS_GY), (bf16*)(ws + WS_GATES)};
        {   pg8::PlainOrder S; S.init(T, 3584, D, D, D, ws + WS_XB, ws + WS_WINT, G, bx);
            pg8::gemm_phase<EpiInproj, pg8::PlainOrder, true>(lds + RING_OFF, S, E, D, D); }
        {
            constexpr int NB = (T / 256) * (3584 / 256), NF = (T / 256) * (4096 / 256);
            const int r = NB % G, nl = G - r;
            Fp8Order S; S.po.init(T, 4096, D / 2, D / 2, D / 2, ws + WS_XF8, ws + WS_WG8, G, bx);
            if (r == 0) { S.w0 = bx; S.wstep = G; S.wn = 1 << 20; }
            else { int a = (NF - 2 * nl) / G; if (a < 0) a = 0; const int NL = nl * (a + 2);
                if (bx >= r) { S.w0 = bx - r; S.wstep = nl; S.wn = a + 2; } else { S.w0 = NL + bx; S.wstep = r; S.wn = 1 << 20; } }
            pg8::gemm_phase<EpiInproj, Fp8Order, true, true>(lds + RING_OFF, S, E, D / 2, D / 2); }
        for (int it = bx; it < S5G * 8; it += G) p0_s5_build(p, lds + RING_OFF, it >> 3, it & 7, tid);
        if (BOTH(1)) GRID_BAR();
    }
    if (IN(2)) {
        const int lane = lane_now();
        if (bx < S5G) { if (!(args.pad & 512)) {
            const int g = bx;
            {   S5EOrder S{1, 2 * g, 2 * g + 2, (const char*)(ws + WS_U5X), (const char*)(ws + WS_BTE)}; EpiS5E E{(float*)(ws + WS_SEND)};
                pg8::gemm_phase<EpiS5E, S5EOrder, true>(lds + RING_OFF, S, E, S5KT, S5KU); }
            asm volatile("s_waitcnt vmcnt(0)" ::: "memory"); __syncthreads();
            __builtin_amdgcn_fence(__ATOMIC_ACQUIRE, "agent"); scan_s5_par(p, lds + RING_OFF, g, lane, wave); asm volatile("s_waitcnt vmcnt(0)" ::: "memory"); __builtin_amdgcn_fence(__ATOMIC_ACQUIRE, "agent");
            __syncthreads();
            {   S5COrder S{1, 4 * g, 4 * g + 4, (const char*)(ws + WS_U5X), (const char*)(ws + WS_BTY)}; EpiS5C E{(const bf16*)(ws + WS_U5X), p.s5_d, (bf16*)(ws + WS_Y5)};
                pg8::gemm_phase<EpiS5C, S5COrder, true>(lds + RING_OFF, S, E, S5KT, S5KT); }
        } } else if (!(args.pad & 1024)) {
            if (wave >= 4) __builtin_amdgcn_s_setprio(1);
            lru_pass<0, true>(p, lds + RING_OFF, G - S5G, bx - S5G, tid, lane, wave, 0, 0);
            lru_mid(p, lds, ctl, args.li, G - S5G, bx - S5G, tid);
            lru_pass<1, true>(p, lds + RING_OFF, G - S5G, bx - S5G, tid, lane, wave, 0, 0);
            __builtin_amdgcn_s_setprio(0);
        }
        if (IN(2) && IN(5)) GRID_BAR();
    }
    if (IN(5)) {
        const int lane = lane_now();
        pg8::PlainOrder S; S.init(T, S5W, S5W, S5W, S5W, ws + WS_Y5, ws + WS_WGLUT, G, bx);
        EpiGlu E{(const bf16*)(ws + WS_Y5), p.s5_b_glu, (bf16*)(ws + WS_OUTC)};
        pg8::gemm_phase<EpiGlu, pg8::PlainOrder, true>(lds + RING_OFF, S, E, S5W, S5W);
        {   const int nun = (T / 256) * (S5W / 256);
            if (bx >= nun && G > nun) { LAS float* scr = (LAS float*)(lds + RING_OFF + wave * 16384); t_run<6>(p, (bx - nun) * NWAVES + wave, (G - nun) * NWAVES, lane, scr, 2048, 8192); }
            else if (G <= nun) { LAS float* scr = (LAS float*)(lds + RING_OFF + wave * 16384); t_run<6>(p, gw, NGW, lane, scr, 2048, 8192); } }
        if (BOTH(5)) GRID_BAR();
    }
    if (IN(6)) {
        ProjOrder S; S.po.init(T, D, D / 2, D / 2, D / 2, ws + WS_OUTC, ws + WS_WPT, G, bx);
        EpiProj E{(const bf16*)(ws + WS_GATES), (bf16*)(ws + WS_MERGED)};
        pg8::gemm_phase<EpiProj, ProjOrder, true, true>(lds + RING_OFF, S, E, D / 2, D / 2);
        if (BOTH(6)) GRID_BAR();
    }
    if (IN(7)) {
        pg8::PlainOrder S; S.init(T, D, D / 2, D / 2, D / 2, ws + WS_MERGED, ws + WS_WOUTT, G, bx);
        EpiWout E{(bf16*)(ws + WS_DELTA), (const bf16*)(ws + WS_XB)};
        pg8::gemm_phase<EpiWout, pg8::PlainOrder, true, true>(lds + RING_OFF, S, E, D / 2, D / 2);
        if (BOTH(7)) GRID_BAR();
    }
    if (IN(8)) {
        const int lane = lane_now();
        if (wave >= 4) __builtin_amdgcn_s_setprio(1);
        router_phase(p, lds + RING_OFF, G, bx, tid, lane, wave, (args.pad & 1) != 0);
        __builtin_amdgcn_s_setprio(0);
        if (BOTH(8)) GRID_BAR();
    }
    LAS unsigned* ecnt = (LAS unsigned*)(lds + ECNT_OFF);
    if (IN(9)) { if (tid < NE) ecnt[tid] = __hip_atomic_load(ctl + CW_ECNT + tid, __ATOMIC_RELAXED, __HIP_MEMORY_SCOPE_AGENT); __syncthreads(); }
    if (IN(9)) {
        int U9 = 0;
        for (int q = 0; q < NE; ++q) U9 += (((int)ecnt[q] + 255) >> 8) * 2;
        U9 = __builtin_amdgcn_readfirstlane(U9);
        for (int rep = (args.pad & 128) ? 0 : 1; rep < 2; ++rep) {
            MoeOrder1 S{G, vcu, ecnt, (const char*)(ws + WS_X1B), (const char*)(ws + WS_WGUT), (const int*)(ws + WS_LISTI), ctl, rep == 1};
            EpiMoe1 E{(const float*)(ws + WS_LISTR), (const float*)(ws + WS_LISTW), (bf16*)(ws + WS_ACT)};
            pg8::gemm_phase<EpiMoe1, MoeOrder1, true, true>(lds + RING_OFF, S, E, D / 2, D / 2); }
        const int U10 = U9 * 4;
        const char* ACTp = (const char*)(ws + WS_ACT); const char* WDp = (const char*)(ws + WS_WDT);
        EpiMoe2 E2{(const int*)(ws + WS_LISTI), (bf16*)(ws + WS_YS8)};
        for (int rep2 = (args.pad & 64) ? 0 : 1; rep2 < 2; ++rep2)
        {
            const bool two = (U9 > G && U9 <= 2 * G);
            const int R2 = U9 - G, GL = G - R2, N0 = 4 * G, N1 = U10 - N0, nh = (3 * R2 < N1) ? 3 * R2 : N1;
            const int nseg = two ? 2 : (U9 + G - 1) / G;
#pragma unroll 1
            for (int sg = 0; sg < nseg; ++sg) {
                int want, u0, us, ul, im; bool wait = true;
                if (two) {
                    if (sg == 0) { want = G * 8; im = 1 << 20;
                        if (vcu >= R2) { const int b = vcu - R2, base = N0 / GL, rem = N0 % GL; u0 = b * base + (b < rem ? b : rem); us = 1; ul = u0 + base + (b < rem ? 1 : 0); } else { u0 = 0; us = 1; ul = 0; wait = false; } }
                    else { want = R2 * 8; if (vcu < R2) { u0 = N0 + 3 * vcu; us = 1; ul = (u0 + 3 < N0 + nh) ? u0 + 3 : N0 + nh; im = 3; } else { u0 = N0 + nh + (G - 1 - vcu); us = GL; ul = U10; im = 1 << 20; } }
                } else { want = U9 - sg * G; want = (want > G ? G : want) * 8; u0 = 4 * sg * G + vcu; us = G; ul = U10; im = 4; }
                if (wait) moe_wait_round(ctl, sg, want);
                MoeOrder2 S{ecnt, ACTp, WDp, u0, us, ul, im};
                pg8::gemm_phase<EpiMoe2, MoeOrder2, true>(lds + RING_OFF, S, E2, EFF, EFF); }
        }
        GRID_BAR();
    }
    if (IN(11)) {
        const int lane = lane_now();
        const unsigned char* YS = (const unsigned char*)(ws + WS_YS8); const bf16* DL = (const bf16*)(ws + WS_DELTA);
#define FIN_LOAD(m_, A, B, C) do { const GAS unsigned* y0_ = (const GAS unsigned*)(YS + (size_t)(2 * (m_)) * D) + lane; \
            const GAS unsigned* y1_ = (const GAS unsigned*)(YS + (size_t)(2 * (m_) + 1) * D) + lane; const GAS u32x2* dd_ = (const GAS u32x2*)(DL + (size_t)(m_) * D) + lane; \
            _Pragma("unroll") for (int j = 0; j < 8; ++j) { A[j] = __builtin_nontemporal_load(y0_ + 64 * j); B[j] = __builtin_nontemporal_load(y1_ + 64 * j); C[j] = __builtin_nontemporal_load(dd_ + 64 * j); } } while (0)
#define FIN_STORE(m_, A, B, C) do { float ss_ = 0.f; f32x4 X[8]; \
            _Pragma("unroll") for (int j = 0; j < 8; ++j) { const f32x2 a01 = __builtin_amdgcn_cvt_pk_f32_fp8(A[j], false), a23 = __builtin_amdgcn_cvt_pk_f32_fp8(A[j], true), b01 = __builtin_amdgcn_cvt_pk_f32_fp8(B[j], false), b23 = __builtin_amdgcn_cvt_pk_f32_fp8(B[j], true); \
                X[j].x = (a01.x + b01.x) * (1.f / 64.f) + __uint_as_float(C[j].x << 16); X[j].y = (a01.y + b01.y) * (1.f / 64.f) + __uint_as_float(C[j].x & 0xffff0000u); \
                X[j].z = (a23.x + b23.x) * (1.f / 64.f) + __uint_as_float(C[j].y << 16); X[j].w = (a23.y + b23.y) * (1.f / 64.f) + __uint_as_float(C[j].y & 0xffff0000u); \
                ss_ += (X[j].x * X[j].x + X[j].y * X[j].y) + (X[j].z * X[j].z + X[j].w * X[j].w); } \
            const float rs_ = rsqrtf(wave_sum(ss_) * (1.f / D) + EPS); GAS f32x4* xo_ = (GAS f32x4*)(p.out + (size_t)(m_) * D) + lane; \
            _Pragma("unroll") for (int j = 0; j < 8; ++j) { const f32x4 nw = *((const f32x4*)p.norm_final_w + lane + 64 * j); __builtin_nontemporal_store(X[j] * rs_ * nw, xo_ + 64 * j); } } while (0)
        {   unsigned ya0[8], ya1[8], yb0[8], yb1[8]; u32x2 da[8], db[8];
            int m = gw;
            if (m < T) { FIN_LOAD(m, ya0, ya1, da);
                for (;;) { const bool hb = m + NGW < T; if (hb) FIN_LOAD(m + NGW, yb0, yb1, db); FIN_STORE(m, ya0, ya1, da); if (!hb) break; m += NGW;
                           const bool ha = m + NGW < T; if (ha) FIN_LOAD(m + NGW, ya0, ya1, da); FIN_STORE(m, yb0, yb1, db); if (!ha) break; m += NGW; } } }
#undef FIN_LOAD
#undef FIN_STORE
    }
    if (args.pad & 256) { for (int q = 0; q < 8; ++q) GRID_BAR(); }
    asm volatile(".Lmk_code_end:" ::: "memory");
#undef IN
#undef BOTH
#undef GRID_BAR
}

extern "C" void kernel_launch(void* const* d_in, const int* in_sizes, int n_in, void* d_out, int out_size, void* d_ws, size_t ws_size, hipStream_t stream) {
    static int grid = 0;
    if (grid == 0) {
        if (n_in != 33 || ws_size < WS_END) { fprintf(stderr, "kernel_launch: bad n_in %d or ws_size %zu < %zu\n", n_in, ws_size, (size_t)WS_END); grid = -1; return; }
        int dev = 0, cus = 0, per_cu = 0;
        if (hipGetDevice(&dev) != hipSuccess || hipDeviceGetAttribute(&cus, hipDeviceAttributeMultiprocessorCount, dev) != hipSuccess) { grid = -1; return; }
        if (hipFuncSetAttribute((const void*)mk_fwd, hipFuncAttributeMaxDynamicSharedMemorySize, LDS_BYTES) != hipSuccess) { fprintf(stderr, "kernel_launch: hipFuncSetAttribute failed\n"); grid = -1; return; }
        if (hipOccupancyMaxActiveBlocksPerMultiprocessor(&per_cu, (const void*)mk_fwd, NWAVES * 64, LDS_BYTES) != hipSuccess || per_cu < 1) { fprintf(stderr, "kernel_launch: occupancy query says %d blocks per CU\n", per_cu); grid = -1; return; }
        (void)hipGetLastError();
        if (cus < 248) { fprintf(stderr, "kernel_launch: %d CUs: the fused mixer phase needs at least 248 workgroups\n", cus); grid = -1; return; }
        grid = cus;
    }
    if (grid < 0) return;
    Args a{};
    const float** f = (const float**)&a.p;
    for (int i = 0; i < 33; ++i) f[i] = (const float*)d_in[i];
    a.p.out = (float*)d_out; a.p.ws = (unsigned char*)d_ws;
    const P& p = a.p; unsigned char* ws = p.ws;
    (void)hipMemsetAsync(ws + WS_CTL, 0, CTL_ZERO_BYTES, stream);
#if defined(PROBE_LO)
    a.ph_lo = 0; a.ph_hi = PROBE_HI; a.li = 0;
#if defined(PROBE_DRY)
    a.pad = PROBE_DRY;
#endif
    hipLaunchKernelGGL(mk_fwd, dim3(grid), dim3(NWAVES * 64), LDS_BYTES, stream, a);
    a.ph_lo = PROBE_LO; a.ph_hi = 12; a.li = 1; a.pad = 0;
    hipLaunchKernelGGL(mk_fwd, dim3(grid), dim3(NWAVES * 64), LDS_BYTES, stream, a);
#else
    a.ph_lo = 0; a.ph_hi = 12; a.li = 0;
#if defined(PROBE_SINGLE)
    a.pad = PROBE_SINGLE;
#endif
    hipLaunchKernelGGL(mk_fwd, dim3(grid), dim3(NWAVES * 64), LDS_BYTES, stream, a);
#endif
}
```
